# Optimizing an MI355X kernel written in HIP

```python
import jax, jax.numpy as jnp
from jax import lax
import numpy as np

D_MODEL = 2048
BATCH = 8
SEQ = 2048
DEPTH = 1

HEAD_DIM = 128
D_MIX = D_MODEL
A_HEADS = (D_MIX // 2) // HEAD_DIM
A_KV_HEADS = 2
A_WINDOW = 128
A_BLOCK = 128
B_HEADS = (D_MIX // 2) // HEAD_DIM
DILATED_PATTERNS = ((128, 1), (512, 4), (2048, 16))
B_BLOCK = 64
ROT_DIM = HEAD_DIM // 4
ROPE_THETA = 500000.0
D_FF = 4 * D_MODEL
PLE_DIM = 256
ALPHA = (2.0 * DEPTH) ** 0.25
BETA = (8.0 * DEPTH) ** -0.25
LN_EPS = 1e-5
RMS_EPS = 1e-6
NEG_INF = -1e30

A_Q = A_HEADS * HEAD_DIM
A_KV = A_KV_HEADS * HEAD_DIM
B_QKV = B_HEADS * HEAD_DIM
D_IN = A_Q + 2 * A_KV + 3 * B_QKV

kernel_name = "hybrid_window_gqa_dilated_attn_deepnorm"


def layer_norm(x, g, b):
    xf = x.astype(jnp.float32)
    mu = jnp.mean(xf, axis=-1, keepdims=True)
    var = jnp.mean(jnp.square(xf - mu), axis=-1, keepdims=True)
    y = (xf - mu) * lax.rsqrt(var + LN_EPS) * g.astype(jnp.float32) + b.astype(jnp.float32)
    return y.astype(x.dtype)


def rms_norm(x, g):
    xf = x.astype(jnp.float32)
    y = xf * lax.rsqrt(jnp.mean(jnp.square(xf), axis=-1, keepdims=True) + RMS_EPS) * g.astype(jnp.float32)
    return y.astype(x.dtype)


def rope_partial(t, cos, sin):
    half = ROT_DIM // 2
    t1 = t[..., :half].astype(jnp.float32)
    t2 = t[..., half:ROT_DIM].astype(jnp.float32)
    rot = jnp.concatenate([t1 * cos - t2 * sin, t2 * cos + t1 * sin], axis=-1)
    return jnp.concatenate([rot.astype(t.dtype), t[..., ROT_DIM:]], axis=-1)


def banded_attention(q, k, v, halo, block, sink=None):
    bt, seq_len, hq, d = q.shape
    hkv = k.shape[2]
    grp = hq // hkv
    nb = -(-seq_len // block)
    lp = nb * block
    kw = block + 2 * halo
    qb = jnp.pad(q, ((0, 0), (0, lp - seq_len), (0, 0), (0, 0))).reshape(bt, nb, block, hkv, grp, d)
    pad_kv = ((0, 0), (halo, halo + lp - seq_len), (0, 0), (0, 0))
    key_idx = (jnp.arange(nb) * block)[:, None] + jnp.arange(kw)[None, :]
    kb = jnp.pad(k, pad_kv)[:, key_idx]
    vb = jnp.pad(v, pad_kv)[:, key_idx]
    s = jnp.einsum('bnqhgd,bnkhd->bnhgqk', qb, kb,
                   preferred_element_type=jnp.float32) * (d ** -0.5)
    qpos = (jnp.arange(nb) * block)[:, None] + jnp.arange(block)[None, :]
    kpos = key_idx - halo
    mask = ((jnp.abs(qpos[:, :, None] - kpos[:, None, :]) <= halo)
            & (kpos >= 0)[:, None, :] & (kpos < seq_len)[:, None, :])
    s = jnp.where(mask[None, :, None, None], s, NEG_INF)
    m = jnp.max(s, axis=-1)
    if sink is not None:
        sk = sink.astype(jnp.float32).reshape(hkv, grp)[None, None, :, :, None]
        m = jnp.maximum(m, sk)
    e = jnp.exp(s - m[..., None])
    denom = jnp.sum(e, axis=-1)
    if sink is not None:
        denom = denom + jnp.exp(sk - m)
    o = jnp.einsum('bnhgqk,bnkhd->bnqhgd', e, vb.astype(jnp.float32))
    o = o / jnp.transpose(denom, (0, 1, 4, 2, 3))[..., None]
    lse = jnp.transpose(m + jnp.log(denom), (0, 1, 4, 2, 3)).reshape(bt, lp, hq)[:, :seq_len]
    o = o.reshape(bt, lp, hq, d)[:, :seq_len].astype(q.dtype)
    return o, lse


def dilated_attention(q, k, v):
    b, s, h, d = q.shape
    outs, lses = [], []
    for window, rate in DILATED_PATTERNS:
        halo = window // (2 * rate)
        sub = s // rate

        def to_res(t):
            return jnp.transpose(t.reshape(b, sub, rate, h, d), (0, 2, 1, 3, 4)).reshape(b * rate, sub, h, d)

        o, lse = banded_attention(to_res(q), to_res(k), to_res(v), halo, B_BLOCK)
        outs.append(jnp.transpose(o.reshape(b, rate, sub, h, d), (0, 2, 1, 3, 4)).reshape(b, s, h, d))
        lses.append(jnp.transpose(lse.reshape(b, rate, sub, h), (0, 2, 1, 3)).reshape(b, s, h))
    w = jax.nn.softmax(jnp.stack(lses, axis=0), axis=0)
    out = jnp.sum(w[..., None] * jnp.stack(outs, axis=0).astype(jnp.float32), axis=0)
    return out.astype(q.dtype)


def setup_inputs(seed: int = 0) -> dict:
    key = jax.random.key(seed)
    ks = jax.random.split(key, 20)
    f32 = jnp.float32
    x = jax.random.normal(ks[0], (BATCH, SEQ, D_MODEL), f32)
    p = jax.random.normal(ks[1], (DEPTH, BATCH, SEQ, PLE_DIM), f32)
    positions = (jnp.arange(SEQ, dtype=jnp.int32)[None, :]
                 + jax.random.randint(ks[2], (BATCH, 1), 0, 512, dtype=jnp.int32))
    col_scale = jnp.concatenate([
        jnp.ones((A_Q + A_KV,), f32), jnp.full((A_KV,), BETA, f32),
        jnp.ones((2 * B_QKV,), f32), jnp.full((B_QKV,), BETA, f32)])
    w_in = jax.random.normal(ks[3], (DEPTH, D_MODEL, D_IN), f32) * (D_MODEL ** -0.5) * col_scale
    sink_a = 0.5 * jax.random.normal(ks[4], (DEPTH, A_HEADS), f32)
    gn_a = 1.0 + 0.02 * jax.random.normal(ks[5], (DEPTH, A_Q), f32)
    gn_b = 1.0 + 0.02 * jax.random.normal(ks[6], (DEPTH, B_QKV), f32)
    w_o = jax.random.normal(ks[7], (DEPTH, D_MIX, D_MODEL), f32) * (D_MIX ** -0.5) * BETA
    ln1_g = 1.0 + 0.02 * jax.random.normal(ks[8], (DEPTH, D_MODEL), f32)
    ln1_b = 0.02 * jax.random.normal(ks[9], (DEPTH, D_MODEL), f32)
    w1 = jax.random.normal(ks[10], (DEPTH, D_MODEL, D_FF), f32) * (D_MODEL ** -0.5) * BETA
    w2 = jax.random.normal(ks[11], (DEPTH, D_FF, D_MODEL), f32) * (D_FF ** -0.5) * BETA
    w_ple = jax.random.normal(ks[12], (DEPTH, PLE_DIM, D_MODEL), f32) * (PLE_DIM ** -0.5) * BETA
    w_ple_gate = jax.random.normal(ks[13], (DEPTH, D_MODEL, D_MODEL), f32) * (D_MODEL ** -0.5)
    ln2_g = 1.0 + 0.02 * jax.random.normal(ks[14], (DEPTH, D_MODEL), f32)
    ln2_b = 0.02 * jax.random.normal(ks[15], (DEPTH, D_MODEL), f32)
    return {"x": x, "p": p, "positions": positions, "w_in": w_in, "sink_a": sink_a,
            "gn_a": gn_a, "gn_b": gn_b, "w_o": w_o, "ln1_g": ln1_g, "ln1_b": ln1_b,
            "w1": w1, "w2": w2, "w_ple": w_ple, "w_ple_gate": w_ple_gate,
            "ln2_g": ln2_g, "ln2_b": ln2_b}


def reference(x, p, positions, w_in, sink_a, gn_a, gn_b, w_o, ln1_g, ln1_b,
              w1, w2, w_ple, w_ple_gate, ln2_g, ln2_b):
    b, s, _ = x.shape
    inv_freq = ROPE_THETA ** (-jnp.arange(0, ROT_DIM, 2, dtype=jnp.float32) / ROT_DIM)
    ang = positions.astype(jnp.float32)[..., None] * inv_freq
    cos = jnp.cos(ang)[:, :, None, :]
    sin = jnp.sin(ang)[:, :, None, :]
    split_at = [A_Q, A_Q + A_KV, A_Q + 2 * A_KV, A_Q + 2 * A_KV + B_QKV, A_Q + 2 * A_KV + 2 * B_QKV]
    h = x
    for i in range(DEPTH):
        proj = h @ w_in[i]
        qa, ka, va, qb, kb, vb = jnp.split(proj, split_at, axis=-1)
        qa = rope_partial(qa.reshape(b, s, A_HEADS, HEAD_DIM), cos, sin)
        ka = rope_partial(ka.reshape(b, s, A_KV_HEADS, HEAD_DIM), cos, sin)
        va = va.reshape(b, s, A_KV_HEADS, HEAD_DIM)
        qb = rope_partial(qb.reshape(b, s, B_HEADS, HEAD_DIM), cos, sin)
        kb = rope_partial(kb.reshape(b, s, B_HEADS, HEAD_DIM), cos, sin)
        vb = vb.reshape(b, s, B_HEADS, HEAD_DIM)
        oa, _ = banded_attention(qa, ka, va, A_WINDOW, A_BLOCK, sink_a[i])
        ob = dilated_attention(qb, kb, vb)
        ya = rms_norm(oa.reshape(b, s, A_Q), gn_a[i])
        yb = rms_norm(ob.reshape(b, s, B_QKV), gn_b[i])
        mix = jnp.concatenate([ya, yb], axis=-1) @ w_o[i]
        h = layer_norm(ALPHA * h + mix, ln1_g[i], ln1_b[i])
        ff = jnp.square(jax.nn.relu(h @ w1[i])) @ w2[i]
        ple = (p[i] @ w_ple[i]) * jax.nn.sigmoid(h @ w_ple_gate[i])
        h = layer_norm(ALPHA * h + ff + ple, ln2_g[i], ln2_b[i])
    return h
```

```cpp
#include <hip/hip_runtime.h>
#include <cstdio>
#include <cstdint>

#define LAS __attribute__((address_space(3)))
typedef unsigned short bf16_t;
typedef short bf16x8 __attribute__((ext_vector_type(8)));
typedef float f32x4 __attribute__((ext_vector_type(4)));
typedef float f32x2 __attribute__((ext_vector_type(2)));
typedef unsigned u32x4 __attribute__((ext_vector_type(4)));
typedef unsigned u32x2 __attribute__((ext_vector_type(2)));

constexpr int NB = 8, SEQ = 2048, M = NB * SEQ;
constexpr int DM = 2048, DIN = 4608, DFF = 8192, PLE = 256, HD = 128;
constexpr int N13 = DFF + DM;
constexpr int C_QA = 0, C_KA = 1024, C_VA = 1280, C_QB = 1536, C_KB = 2560, C_VB = 3584;
constexpr float ALPHA = 1.18920711500272f;
constexpr float LN_EPS = 1e-5f, RMS_EPS = 1e-6f;
constexpr float SM_SCALE = 0.08838834764831845f;

constexpr size_t MiB = 1u << 20;
constexpr size_t WS_CTL = 0, WS_ROPE = 1 * MiB, WS_SSQ = 3 * MiB;
constexpr size_t WS_WINT = 6 * MiB, WS_WOT = 24 * MiB, WS_W13T = 32 * MiB, WS_W2T = 72 * MiB, WS_WPT = 104 * MiB;
constexpr size_t WS_PB = 105 * MiB, WS_H1B = 113 * MiB, WS_XB = 113 * MiB  , WS_GATE = 177 * MiB;
constexpr size_t WS_PROJ = 241 * MiB, WS_OCAT = 385 * MiB, WS_HID = 241 * MiB  , WS_END = 497 * MiB;

__device__ __forceinline__ unsigned f2bf(float f) { unsigned u = __builtin_bit_cast(unsigned, f); return (u + 0x7fffu + ((u >> 16) & 1u)) >> 16; }
__device__ __forceinline__ unsigned pk2(float lo, float hi) { return f2bf(lo) | (f2bf(hi) << 16); }
__device__ __forceinline__ float bf2f(unsigned short b) { return __builtin_bit_cast(float, (unsigned)b << 16); }
__device__ __forceinline__ float wave_sum(float v) {
#pragma unroll
    for (int o = 1; o < 64; o <<= 1) v += __shfl_xor(v, o);
    return v;
}
__device__ __forceinline__ float wave_max(float v) {
#pragma unroll
    for (int o = 1; o < 64; o <<= 1) v = fmaxf(v, __shfl_xor(v, o));
    return v;
}

__device__ __forceinline__ void transpose_item(const float* W, int K, int N, bf16_t* WT, int row_off, const float* g, LAS float* scr, int item, int lane) {
    const int nblk = N / 32, kb = item / nblk, nb = item % nblk, k0 = 64 * kb, n0 = 32 * nb;
#pragma unroll 8
    for (int i = 0; i < 32; ++i) { const int kk = 2 * i + (lane >> 5); float v = W[(size_t)(k0 + kk) * N + n0 + (lane & 31)]; if (g) v *= g[k0 + kk]; scr[kk * 33 + (lane & 31)] = v; }
    asm volatile("s_waitcnt lgkmcnt(0)" ::: "memory");
    const int c = lane & 7;
#pragma unroll
    for (int j = 0; j < 4; ++j) { const int n = (lane >> 3) + 8 * j; const LAS float* s = scr + (8 * c) * 33 + n;
        u32x4 o; o.x = pk2(s[0 * 33], s[1 * 33]); o.y = pk2(s[2 * 33], s[3 * 33]); o.z = pk2(s[4 * 33], s[5 * 33]); o.w = pk2(s[6 * 33], s[7 * 33]);
        *(u32x4*)(WT + (size_t)(row_off + n0 + n) * K + k0 + 8 * c) = o; }
    asm volatile("s_waitcnt lgkmcnt(0)" ::: "memory");
}
__device__ __forceinline__ void sincos_d(double x, float& s, float& c) {
    const double k = __builtin_rint(x * 0.63661977236758134308);
    double r = __builtin_fma(-k, 1.57079632679489655800e+00, x); r = __builtin_fma(-k, 6.12323399573676603587e-17, r);
    const double r2 = r * r;
    double sp = -1.0 / 1307674368000.0; sp = sp * r2 + 1.0 / 6227020800.0; sp = sp * r2 - 1.0 / 39916800.0; sp = sp * r2 + 1.0 / 362880.0; sp = sp * r2 - 1.0 / 5040.0; sp = sp * r2 + 1.0 / 120.0; sp = sp * r2 - 1.0 / 6.0; sp = sp * r2 + 1.0;
    const double sn = sp * r;
    double cp = 1.0 / 20922789888000.0; cp = cp * r2 - 1.0 / 87178291200.0; cp = cp * r2 + 1.0 / 479001600.0; cp = cp * r2 - 1.0 / 3628800.0; cp = cp * r2 + 1.0 / 40320.0; cp = cp * r2 - 1.0 / 720.0; cp = cp * r2 + 1.0 / 24.0; cp = cp * r2 - 0.5; cp = cp * r2 + 1.0;
    const int q = ((int)k) & 3;
    const double ss = (q == 0) ? sn : (q == 1) ? cp : (q == 2) ? -sn : -cp;
    const double cc = (q == 0) ? cp : (q == 1) ? -sn : (q == 2) ? -cp : sn;
    s = (float)ss; c = (float)cc;
}
struct PrepArgs { const float *x, *p, *w_in, *gn_a, *gn_b, *w_o, *w1, *w2, *w_ple, *w_gate; const int* pos; unsigned char* ws; };
__device__ __forceinline__ void prep_phase(const PrepArgs& a, LAS unsigned char* lds, int vb, int nvb) {
    const int tid = threadIdx.x, lane = tid & 63, wave = tid >> 6;
    LAS float* scr = (LAS float*)(lds + wave * 16384);
    const int gw = vb * 8 + wave, ngw = nvb * 8;
    bf16_t* WinT = (bf16_t*)(a.ws + WS_WINT); bf16_t* WoT = (bf16_t*)(a.ws + WS_WOT); bf16_t* W13T = (bf16_t*)(a.ws + WS_W13T);
    bf16_t* W2T = (bf16_t*)(a.ws + WS_W2T); bf16_t* WpT = (bf16_t*)(a.ws + WS_WPT);
    constexpr int I_IN = (DM / 64) * (DIN / 32), I_O = (DM / 64) * (DM / 32), I_1 = (DM / 64) * (DFF / 32), I_G = I_O, I_2 = (DFF / 64) * (DM / 32), I_P = (PLE / 64) * (DM / 32);
    constexpr int NITEMS = I_IN + I_O + I_1 + I_G + I_2 + I_P;
    for (int it = gw; it < NITEMS; it += ngw) {
        int r = it;
        if (r < I_IN) { transpose_item(a.w_in, DM, DIN, WinT, 0, nullptr, scr, r, lane); continue; } r -= I_IN;
        if (r < I_O) { const int kb = r / (DM / 32);
            transpose_item(a.w_o, DM, DM, WoT, 0, (kb < 16) ? a.gn_a : (a.gn_b - 1024), scr, r, lane); continue; } r -= I_O;
        if (r < I_1) { transpose_item(a.w1, DM, DFF, W13T, 0, nullptr, scr, r, lane); continue; } r -= I_1;
        if (r < I_G) { transpose_item(a.w_gate, DM, DM, W13T, DFF, nullptr, scr, r, lane); continue; } r -= I_G;
        if (r < I_2) { transpose_item(a.w2, DFF, DM, W2T, 0, nullptr, scr, r, lane); continue; } r -= I_2;
        transpose_item(a.w_ple, PLE, DM, WpT, 0, nullptr, scr, r, lane);
    }
    bf16_t* XB = (bf16_t*)(a.ws + WS_XB); bf16_t* PB = (bf16_t*)(a.ws + WS_PB);
    const size_t gt = (size_t)vb * 512 + tid, ngt = (size_t)nvb * 512;
    for (size_t i = gt; i < (size_t)M * DM / 8; i += ngt) { const f32x4 v0 = ((const f32x4*)a.x)[2 * i], v1 = ((const f32x4*)a.x)[2 * i + 1];
        u32x4 o; o.x = pk2(v0.x, v0.y); o.y = pk2(v0.z, v0.w); o.z = pk2(v1.x, v1.y); o.w = pk2(v1.z, v1.w); ((u32x4*)XB)[i] = o; }
    for (size_t i = gt; i < (size_t)M * PLE / 8; i += ngt) { const f32x4 v0 = ((const f32x4*)a.p)[2 * i], v1 = ((const f32x4*)a.p)[2 * i + 1];
        u32x4 o; o.x = pk2(v0.x, v0.y); o.y = pk2(v0.z, v0.w); o.z = pk2(v1.x, v1.y); o.w = pk2(v1.z, v1.w); ((u32x4*)PB)[i] = o; }
    float* rope = (float*)(a.ws + WS_ROPE);
    for (size_t i = gt; i < (size_t)M * 16; i += ngt) { const int m = (int)(i >> 4), j = (int)(i & 15);
        const double invf = ::exp2(-(double)j * (1.0 / 16.0) * 18.931568569324174);
        float s, c; sincos_d((double)a.pos[m] * invf, s, c); rope[(size_t)m * 32 + j] = c; rope[(size_t)m * 32 + 16 + j] = s; }
}
namespace g8 {
constexpr int BM = 256, BK = 64, HALF = 128, HTB = HALF * BK * 2;
__device__ __forceinline__ int lds_byte(int r, int c) { const int st = (r >> 4) * 2 + (c >> 5), rr = r & 15, cc = c & 31, ob = rr * 64 + cc * 2; return st * 1024 + (ob ^ (((ob >> 9) & 1) << 5)); }
__device__ __forceinline__ int perm32(int rho) { const int n = rho >> 4, i = rho & 15; return 8 * (i >> 2) + 4 * n + (i & 3); }
struct Unit { int pm, pn; };
struct Seg { const bf16_t* A; const bf16_t* Bt; int lda, ldb, K; };
#define G8_SA(b, h) (((b) * 2 + (h)) * g8::HTB)
#define G8_SB(b, h) ((4 + (b) * 2 + (h)) * g8::HTB)

template <class Epi>
__device__ __forceinline__ void gemm_simple(LAS unsigned char* lds, const Seg s0, const Seg s1, int nM, int nN, const Epi& E, int vb, int nvb) {
    const int tid = threadIdx.x, wid = __builtin_amdgcn_readfirstlane(tid >> 6), lane = tid & 63, wr = wid >> 2, wc = wid & 3, fr = lane & 15, fq = lane >> 4;
    const int aoff = lds_byte(wr * 64 + fr, fq * 8), boff = lds_byte(wc * 32 + fr, fq * 8);
    for (int unit = vb; unit < nM * nN; unit += nvb) {
        Unit u; u.pm = unit / nN; u.pn = unit % nN;
        f32x4 acc[2][2][4][2];
#pragma unroll
        for (int a = 0; a < 2; ++a)
#pragma unroll
            for (int b = 0; b < 2; ++b)
#pragma unroll
                for (int m = 0; m < 4; ++m)
#pragma unroll
                    for (int n = 0; n < 2; ++n) acc[a][b][m][n] = (f32x4){0.f, 0.f, 0.f, 0.f};
        for (int sg = 0; sg < 2; ++sg) {
            const Seg s = sg == 0 ? s0 : s1;
            if (s.K == 0) continue;
            for (int kt = 0; kt < s.K / BK; ++kt) {
                __syncthreads();
#pragma unroll
                for (int i = 0; i < 4; ++i) {
                    const int q = tid + 512 * i, r256 = q >> 3, c8 = q & 7, h = r256 >> 7, r = r256 & 127;
                    const u32x4 va = *(const u32x4*)(s.A + (size_t)(u.pm * BM + r256) * s.lda + kt * BK + c8 * 8);
                    *(LAS u32x4*)(lds + G8_SA(0, h) + lds_byte(r, c8 * 8)) = va;
                    const int rb = Epi::PERM ? ((r & ~31) + perm32(r & 31)) : r;
                    const u32x4 vbv = *(const u32x4*)(s.Bt + (size_t)(u.pn * BM + h * HALF + rb) * s.ldb + kt * BK + c8 * 8);
                    *(LAS u32x4*)(lds + G8_SB(0, h) + lds_byte(r, c8 * 8)) = vbv;
                }
                __syncthreads();
                bf16x8 At[4][2], B0[2][2], B1[2][2];
#pragma unroll
                for (int n = 0; n < 2; ++n)
#pragma unroll
                    for (int k = 0; k < 2; ++k) { B0[n][k] = *(const LAS bf16x8*)(lds + G8_SB(0, 0) + boff + n * 2048 + k * 1024); B1[n][k] = *(const LAS bf16x8*)(lds + G8_SB(0, 1) + boff + n * 2048 + k * 1024); }
#pragma unroll
                for (int ai = 0; ai < 2; ++ai) {
#pragma unroll
                    for (int m = 0; m < 4; ++m)
#pragma unroll
                        for (int k = 0; k < 2; ++k) At[m][k] = *(const LAS bf16x8*)(lds + G8_SA(0, ai) + aoff + m * 2048 + k * 1024);
#pragma unroll
                    for (int m = 0; m < 4; ++m)
#pragma unroll
                        for (int n = 0; n < 2; ++n)
#pragma unroll
                            for (int k = 0; k < 2; ++k) {
                                acc[ai][0][m][n] = __builtin_amdgcn_mfma_f32_16x16x32_bf16(B0[n][k], At[m][k], acc[ai][0][m][n], 0, 0, 0);
                                acc[ai][1][m][n] = __builtin_amdgcn_mfma_f32_16x16x32_bf16(B1[n][k], At[m][k], acc[ai][1][m][n], 0, 0, 0);
                            }
                }
            }
            if (sg == 0 && s1.K != 0) E.mid(acc, u, wr, wc, fr, fq);
        }
        E(acc, u, wr, wc, fr, fq);
    }
}
}

struct Epi1 {
    static constexpr bool PERM = true;
    bf16_t* O; const float* rope;
    __device__ __forceinline__ void mid(f32x4 (&)[2][2][4][2], const g8::Unit&, int, int, int, int) const {}
    __device__ __forceinline__ void operator()(const f32x4 (&acc)[2][2][4][2], const g8::Unit& u, int wr, int wc, int fr, int fq) const {
        const int row0 = u.pm * 256 + wr * 64 + fr, col0 = u.pn * 256 + wc * 32 + 8 * fq;
        const float sgn = fq < 2 ? -1.f : 1.f;
#pragma unroll
        for (int ai = 0; ai < 2; ++ai)
#pragma unroll
            for (int m = 0; m < 4; ++m) {
                const int row = row0 + ai * 128 + m * 16;
                const float* rp = rope + (size_t)row * 32 + 8 * (fq & 1);
                const f32x4 c0 = *(const f32x4*)(rp), c1 = *(const f32x4*)(rp + 4), s0 = *(const f32x4*)(rp + 16), s1 = *(const f32x4*)(rp + 20);
#pragma unroll
                for (int bj = 0; bj < 2; ++bj) {
                    const int hh = 2 * u.pn + bj;
                    const bool is_rope = (wc == 0) && (hh < 10 || (hh >= 12 && hh < 28));
                    f32x4 v0 = acc[ai][bj][m][0], v1 = acc[ai][bj][m][1];
                    if (is_rope) {
                        f32x4 o0, o1;
#pragma unroll
                        for (int j = 0; j < 4; ++j) { o0[j] = __shfl_xor(v0[j], 32); o1[j] = __shfl_xor(v1[j], 32); }
                        v0 = v0 * c0 + (o0 * s0) * sgn; v1 = v1 * c1 + (o1 * s1) * sgn;
                    }
                    u32x4 w; w.x = pk2(v0[0], v0[1]); w.y = pk2(v0[2], v0[3]); w.z = pk2(v1[0], v1[1]); w.w = pk2(v1[2], v1[3]);
                    *(u32x4*)(O + (size_t)row * DIN + col0 + bj * 128) = w;
                }
            }
    }
};
struct Epi2 {
    static constexpr bool PERM = false;
    const float* x; float* V; const float* ssq;
    __device__ __forceinline__ void scales(int row, float& ra, float& rb) const {
        const f32x4* sp = (const f32x4*)(ssq + (size_t)row * 16);
        const f32x4 a0 = sp[0], a1 = sp[1], b0 = sp[2], b1 = sp[3];
        const float sa = (a0[0] + a0[1]) + (a0[2] + a0[3]) + (a1[0] + a1[1]) + (a1[2] + a1[3]);
        const float sb = (b0[0] + b0[1]) + (b0[2] + b0[3]) + (b1[0] + b1[1]) + (b1[2] + b1[3]);
        ra = 1.0f / sqrtf(sa * (1.0f / 1024.0f) + RMS_EPS); rb = 1.0f / sqrtf(sb * (1.0f / 1024.0f) + RMS_EPS);
    }
    __device__ __forceinline__ void mid(f32x4 (&acc)[2][2][4][2], const g8::Unit& u, int wr, int wc, int fr, int fq) const {
#pragma unroll
        for (int ai = 0; ai < 2; ++ai)
#pragma unroll
            for (int m = 0; m < 4; ++m) { float ra, rb; scales(u.pm * 256 + ai * 128 + wr * 64 + m * 16 + fr, ra, rb); const float f = ra / rb;
#pragma unroll
                for (int bj = 0; bj < 2; ++bj)
#pragma unroll
                    for (int n = 0; n < 2; ++n) acc[ai][bj][m][n] = acc[ai][bj][m][n] * f; }
    }
    __device__ __forceinline__ void operator()(const f32x4 (&acc)[2][2][4][2], const g8::Unit& u, int wr, int wc, int fr, int fq) const {
        const int col0 = u.pn * 256 + wc * 32 + 4 * fq;
#pragma unroll
        for (int ai = 0; ai < 2; ++ai)
#pragma unroll
            for (int m = 0; m < 4; ++m) { const int row = u.pm * 256 + ai * 128 + wr * 64 + m * 16 + fr; float ra, rb; scales(row, ra, rb);
#pragma unroll
                for (int bj = 0; bj < 2; ++bj)
#pragma unroll
                    for (int n = 0; n < 2; ++n) { const size_t off = (size_t)row * DM + col0 + bj * 128 + n * 16;
                        const f32x4 xv = *(const f32x4*)(x + off); *(f32x4*)(V + off) = xv * ALPHA + acc[ai][bj][m][n] * rb; } }
    }
};
struct Epi3 {
    static constexpr bool PERM = true;
    bf16_t* HID; bf16_t* GATE;
    __device__ __forceinline__ void mid(f32x4 (&)[2][2][4][2], const g8::Unit&, int, int, int, int) const {}
    __device__ __forceinline__ void operator()(const f32x4 (&acc)[2][2][4][2], const g8::Unit& u, int wr, int wc, int fr, int fq) const {
        const bool is_gate = u.pn >= DFF / 256;
        bf16_t* base = is_gate ? GATE : HID; const int ldc = is_gate ? DM : DFF; const int colt = (is_gate ? u.pn - DFF / 256 : u.pn) * 256;
        const int row0 = u.pm * 256 + wr * 64 + fr, col0 = colt + wc * 32 + 8 * fq;
#pragma unroll
        for (int ai = 0; ai < 2; ++ai)
#pragma unroll
            for (int m = 0; m < 4; ++m)
#pragma unroll
                for (int bj = 0; bj < 2; ++bj) { f32x4 v0 = acc[ai][bj][m][0], v1 = acc[ai][bj][m][1];
                    if (is_gate) {
#pragma unroll
                        for (int j = 0; j < 4; ++j) { v0[j] = 1.0f / (1.0f + __expf(-v0[j])); v1[j] = 1.0f / (1.0f + __expf(-v1[j])); }
                    } else {
#pragma unroll
                        for (int j = 0; j < 4; ++j) { const float a = fmaxf(v0[j], 0.f), b = fmaxf(v1[j], 0.f); v0[j] = a * a; v1[j] = b * b; }
                    }
                    u32x4 w; w.x = pk2(v0[0], v0[1]); w.y = pk2(v0[2], v0[3]); w.z = pk2(v1[0], v1[1]); w.w = pk2(v1[2], v1[3]);
                    *(u32x4*)(base + (size_t)(row0 + ai * 128 + m * 16) * ldc + col0 + bj * 128) = w; }
    }
};
struct Epi4 {
    static constexpr bool PERM = false;
    const bf16_t* GATE; float* H;
    __device__ __forceinline__ void mid(f32x4 (&acc)[2][2][4][2], const g8::Unit& u, int wr, int wc, int fr, int fq) const {
        const int col0 = u.pn * 256 + wc * 32 + 4 * fq;
#pragma unroll
        for (int ai = 0; ai < 2; ++ai)
#pragma unroll
            for (int m = 0; m < 4; ++m) { const int row = u.pm * 256 + ai * 128 + wr * 64 + m * 16 + fr;
#pragma unroll
                for (int bj = 0; bj < 2; ++bj)
#pragma unroll
                    for (int n = 0; n < 2; ++n) { const u32x2 g = *(const u32x2*)(GATE + (size_t)row * DM + col0 + bj * 128 + n * 16);
                        f32x4 gv; gv[0] = bf2f((unsigned short)(g.x & 0xffff)); gv[1] = bf2f((unsigned short)(g.x >> 16)); gv[2] = bf2f((unsigned short)(g.y & 0xffff)); gv[3] = bf2f((unsigned short)(g.y >> 16));
                        acc[ai][bj][m][n] = acc[ai][bj][m][n] * gv; } }
    }
    __device__ __forceinline__ void operator()(const f32x4 (&acc)[2][2][4][2], const g8::Unit& u, int wr, int wc, int fr, int fq) const {
        const int col0 = u.pn * 256 + wc * 32 + 4 * fq;
#pragma unroll
        for (int ai = 0; ai < 2; ++ai)
#pragma unroll
            for (int m = 0; m < 4; ++m) { const int row = u.pm * 256 + ai * 128 + wr * 64 + m * 16 + fr;
#pragma unroll
                for (int bj = 0; bj < 2; ++bj)
#pragma unroll
                    for (int n = 0; n < 2; ++n) { const size_t off = (size_t)row * DM + col0 + bj * 128 + n * 16;
                        const f32x4 hv = *(const f32x4*)(H + off); *(f32x4*)(H + off) = hv * ALPHA + acc[ai][bj][m][n]; } }
    }
};

__device__ __forceinline__ void ln_rows(float* V, bf16_t* OB, const float* g, const float* b, int vb, int nvb) {
    const int tid = threadIdx.x, lane = tid & 63, wave = tid >> 6;
    for (int row = vb * 8 + wave; row < M; row += nvb * 8) {
        f32x4* vr = (f32x4*)(V + (size_t)row * DM) + lane;
        f32x4 v[8]; float s = 0.f;
#pragma unroll
        for (int j = 0; j < 8; ++j) { v[j] = vr[64 * j]; s += (v[j][0] + v[j][1]) + (v[j][2] + v[j][3]); }
        const float mean = wave_sum(s) * (1.0f / DM); float s2 = 0.f;
#pragma unroll
        for (int j = 0; j < 8; ++j) { v[j] = v[j] - mean; s2 += (v[j][0] * v[j][0] + v[j][1] * v[j][1]) + (v[j][2] * v[j][2] + v[j][3] * v[j][3]); }
        const float rstd = 1.0f / sqrtf(wave_sum(s2) * (1.0f / DM) + LN_EPS);
#pragma unroll
        for (int j = 0; j < 8; ++j) { const f32x4 gg = ((const f32x4*)g)[lane + 64 * j], bb = ((const f32x4*)b)[lane + 64 * j];
            const f32x4 o = v[j] * rstd * gg + bb; vr[64 * j] = o;
            if (OB) { u32x2 w; w.x = pk2(o[0], o[1]); w.y = pk2(o[2], o[3]); *((u32x2*)(OB + (size_t)row * DM) + lane + 64 * j) = w; } }
    }
}

__device__ __forceinline__ float dot128(const bf16x8 (&q)[16], const bf16_t* kp) {
    float d = 0.f;
#pragma unroll
    for (int i = 0; i < 16; ++i) { const bf16x8 kv = *(const bf16x8*)(kp + 8 * i);
#pragma unroll
        for (int j = 0; j < 8; ++j) d += bf2f((unsigned short)q[i][j]) * bf2f((unsigned short)kv[j]); }
    return d;
}
__device__ __forceinline__ void attn_naive(const bf16_t* proj, const float* sink, bf16_t* ocat, float* ssq, int vb, int nvb) {
    const int tid = threadIdx.x, lane = tid & 63, wave = tid >> 6;
    for (int item = vb * 8 + wave; item < M * 16; item += nvb * 8) {
        const int m = item >> 4, hs = item & 15, b = m / SEQ, s = m % SEQ;
        const bool isA = hs < 8; const int h = hs & 7;
        const int qc = isA ? C_QA + h * HD : C_QB + h * HD, kc = isA ? C_KA + (h >> 2) * HD : C_KB + h * HD, vc = isA ? C_VA + (h >> 2) * HD : C_VB + h * HD;
        bf16x8 q[16];
#pragma unroll
        for (int i = 0; i < 16; ++i) q[i] = *(const bf16x8*)(proj + (size_t)m * DIN + qc + 8 * i);
        const bf16_t* kb = proj + (size_t)b * SEQ * DIN + kc; const bf16_t* vbp = proj + (size_t)b * SEQ * DIN + vc;
        float sc[9]; int kn[9]; float mx = -1e30f;
        if (isA) {
#pragma unroll
            for (int i = 0; i < 9; ++i) { const int n = s - 128 + lane + 64 * i; const bool ok = (i < 5) && n >= 0 && n < SEQ && n <= s + 128;
                kn[i] = ok ? n : -1; sc[i] = ok ? dot128(q, kb + (size_t)n * DIN) * SM_SCALE : -1e30f; mx = fmaxf(mx, sc[i]); }
        } else {
#pragma unroll
            for (int i = 0; i < 9; ++i) { const int pi = i / 3, r = (pi == 0) ? 1 : (pi == 1) ? 4 : 16; const int j = lane - 64 + 64 * (i % 3); const int n = s + r * j; const bool ok = j <= 64 && n >= 0 && n < SEQ;
                kn[i] = ok ? n : -1; sc[i] = ok ? dot128(q, kb + (size_t)n * DIN) * SM_SCALE : -1e30f; mx = fmaxf(mx, sc[i]); }
        }
        mx = wave_max(mx); const float sk = isA ? sink[h] : -1e30f; mx = fmaxf(mx, sk);
        float den = 0.f; float pr[9];
#pragma unroll
        for (int i = 0; i < 9; ++i) { pr[i] = kn[i] >= 0 ? __expf(sc[i] - mx) : 0.f; den += pr[i]; }
        den = wave_sum(den) + (isA ? __expf(sk - mx) : 0.f);
        float o0 = 0.f, o1 = 0.f;
#pragma unroll
        for (int i = 0; i < 9; ++i) {
            if (isA && i >= 5) continue;
            for (int l = 0; l < 64; ++l) { const float pv = __shfl(pr[i], l); const int n = __shfl(kn[i], l);
                if (n >= 0) { const unsigned vv = *(const unsigned*)(vbp + (size_t)n * DIN + 2 * lane); o0 += pv * bf2f((unsigned short)(vv & 0xffff)); o1 += pv * bf2f((unsigned short)(vv >> 16)); } }
        }
        const float inv = 1.0f / den; o0 *= inv; o1 *= inv;
        *(unsigned*)(ocat + (size_t)m * DM + hs * HD + 2 * lane) = pk2(o0, o1);
        const float q2 = wave_sum(o0 * o0 + o1 * o1);
        if (lane == 0) ssq[(size_t)m * 16 + hs] = q2;
    }
}

struct Args { const float* in[16]; float* out; unsigned char* ws; };
__device__ __forceinline__ PrepArgs mk_prep(const Args& a) { PrepArgs p; p.x = a.in[0]; p.p = a.in[1]; p.pos = (const int*)a.in[2]; p.w_in = a.in[3]; p.gn_a = a.in[5]; p.gn_b = a.in[6]; p.w_o = a.in[7];
    p.w1 = a.in[10]; p.w2 = a.in[11]; p.w_ple = a.in[12]; p.w_gate = a.in[13]; p.ws = a.ws; return p; }
extern __shared__ __attribute__((aligned(16))) unsigned char dyn_lds[];
__global__ void __launch_bounds__(512) k_prep(Args a) { const PrepArgs p = mk_prep(a); prep_phase(p, (LAS unsigned char*)dyn_lds, blockIdx.x, gridDim.x); }
__global__ void __launch_bounds__(512) k_gemm1(Args a) {
    g8::Seg s0{(const bf16_t*)(a.ws + WS_XB), (const bf16_t*)(a.ws + WS_WINT), DM, DM, DM}, s1{nullptr, nullptr, 0, 0, 0};
    Epi1 E{(bf16_t*)(a.ws + WS_PROJ), (const float*)(a.ws + WS_ROPE)};
    g8::gemm_simple(( LAS unsigned char*)dyn_lds, s0, s1, M / 256, DIN / 256, E, blockIdx.x, gridDim.x);
}
__global__ void __launch_bounds__(512) k_attn(Args a) { attn_naive((const bf16_t*)(a.ws + WS_PROJ), a.in[4], (bf16_t*)(a.ws + WS_OCAT), (float*)(a.ws + WS_SSQ), blockIdx.x, gridDim.x); }
__global__ void __launch_bounds__(512) k_gemm2(Args a) {
    const bf16_t* oc = (const bf16_t*)(a.ws + WS_OCAT); const bf16_t* wo = (const bf16_t*)(a.ws + WS_WOT);
    g8::Seg s0{oc, wo, DM, DM, 1024}, s1{oc + 1024, wo + 1024, DM, DM, 1024};
    Epi2 E{a.in[0], a.out, (const float*)(a.ws + WS_SSQ)};
    g8::gemm_simple((LAS unsigned char*)dyn_lds, s0, s1, M / 256, DM / 256, E, blockIdx.x, gridDim.x);
}
__global__ void __launch_bounds__(512) k_ln1(Args a) { ln_rows(a.out, (bf16_t*)(a.ws + WS_H1B), a.in[8], a.in[9], blockIdx.x, gridDim.x); }
__global__ void __launch_bounds__(512) k_gemm3(Args a) {
    g8::Seg s0{(const bf16_t*)(a.ws + WS_H1B), (const bf16_t*)(a.ws + WS_W13T), DM, DM, DM}, s1{nullptr, nullptr, 0, 0, 0};
    Epi3 E{(bf16_t*)(a.ws + WS_HID), (bf16_t*)(a.ws + WS_GATE)};
    g8::gemm_simple((LAS unsigned char*)dyn_lds, s0, s1, M / 256, N13 / 256, E, blockIdx.x, gridDim.x);
}
__global__ void __launch_bounds__(512) k_gemm4(Args a) {
    g8::Seg s0{(const bf16_t*)(a.ws + WS_PB), (const bf16_t*)(a.ws + WS_WPT), PLE, PLE, PLE}, s1{(const bf16_t*)(a.ws + WS_HID), (const bf16_t*)(a.ws + WS_W2T), DFF, DFF, DFF};
    Epi4 E{(const bf16_t*)(a.ws + WS_GATE), a.out};
    g8::gemm_simple((LAS unsigned char*)dyn_lds, s0, s1, M / 256, DM / 256, E, blockIdx.x, gridDim.x);
}
__global__ void __launch_bounds__(512) k_ln2(Args a) { ln_rows(a.out, nullptr, a.in[14], a.in[15], blockIdx.x, gridDim.x); }

extern "C" void kernel_launch(void* const* d_in, const int* in_sizes, int n_in, void* d_out, int out_size, void* d_ws, size_t ws_size, hipStream_t stream) {
    if (n_in != 16 || out_size != M * DM || ws_size < WS_END) { fprintf(stderr, "kernel_launch: unexpected shapes (n_in %d out %d ws %zu)\n", n_in, out_size, ws_size); return; }
    Args a{};
    for (int i = 0; i < 16; ++i) a.in[i] = (const float*)d_in[i];
    a.out = (float*)d_out; a.ws = (unsigned char*)d_ws;
    constexpr int LDS = 131072;
    static bool attr = false;
    if (!attr) { attr = true;
        hipFuncSetAttribute((const void*)k_prep, hipFuncAttributeMaxDynamicSharedMemorySize, LDS); hipFuncSetAttribute((const void*)k_gemm1, hipFuncAttributeMaxDynamicSharedMemorySize, LDS);
        hipFuncSetAttribute((const void*)k_gemm2, hipFuncAttributeMaxDynamicSharedMemorySize, LDS); hipFuncSetAttribute((const void*)k_gemm3, hipFuncAttributeMaxDynamicSharedMemorySize, LDS);
        hipFuncSetAttribute((const void*)k_gemm4, hipFuncAttributeMaxDynamicSharedMemorySize, LDS); }
    hipLaunchKernelGGL(k_prep, dim3(1024), dim3(512), LDS, stream, a);
    hipLaunchKernelGGL(k_gemm1, dim3(M / 256 * DIN / 256), dim3(512), LDS, stream, a);
    hipLaunchKernelGGL(k_attn, dim3(4096), dim3(512), 0, stream, a);
    hipLaunchKernelGGL(k_gemm2, dim3(M / 256 * DM / 256), dim3(512), LDS, stream, a);
    hipLaunchKernelGGL(k_ln1, dim3(2048), dim3(512), 0, stream, a);
    hipLaunchKernelGGL(k_gemm3, dim3(M / 256 * N13 / 256), dim3(512), LDS, stream, a);
    hipLaunchKernelGGL(k_gemm4, dim3(M / 256 * DM / 256), dim3(512), LDS, stream, a);
    hipLaunchKernelGGL(k_ln2, dim3(2048), dim3(512), 0, stream, a);
}
```

```cpp
#include <hip/hip_runtime.h>
#include <hip/hip_cooperative_groups.h>
namespace cg = cooperative_groups;
#include <cstdio>
#include <cstdint>

#define LAS __attribute__((address_space(3)))
typedef unsigned short bf16_t;
typedef short bf16x8 __attribute__((ext_vector_type(8)));
typedef float f32x4 __attribute__((ext_vector_type(4)));
typedef float f32x2 __attribute__((ext_vector_type(2)));
typedef unsigned u32x4 __attribute__((ext_vector_type(4)));
typedef unsigned u32x2 __attribute__((ext_vector_type(2)));

constexpr int NB = 8, SEQ = 2048, M = NB * SEQ;
constexpr int DM = 2048, DIN = 4608, DFF = 8192, PLE = 256, HD = 128;
constexpr int N13 = DFF + DM;
constexpr int C_QA = 0, C_KA = 1024, C_VA = 1280, C_QB = 1536, C_KB = 2560, C_VB = 3584;
constexpr float ALPHA = 1.18920711500272f;
constexpr float LN_EPS = 1e-5f, RMS_EPS = 1e-6f;
constexpr float SM_SCALE = 0.08838834764831845f;

constexpr size_t MiB = 1u << 20;
constexpr size_t WS_CTL = 0, WS_ROPE = 1 * MiB, WS_SSQ = 3 * MiB;
constexpr size_t WS_WINT = 6 * MiB, WS_WOT = 24 * MiB, WS_W13T = 32 * MiB, WS_W2T = 72 * MiB, WS_WPT = 104 * MiB;
constexpr size_t WS_PB = 105 * MiB, WS_H1B = 113 * MiB, WS_XB = 113 * MiB  , WS_GATE = 177 * MiB;
constexpr size_t WS_PROJ = 241 * MiB, WS_OCAT = 385 * MiB, WS_HID = 241 * MiB  , WS_END = 497 * MiB;

__device__ __forceinline__ unsigned f2bf(float f) { unsigned u = __builtin_bit_cast(unsigned, f); return (u + 0x7fffu + ((u >> 16) & 1u)) >> 16; }
__device__ __forceinline__ unsigned pk2(float lo, float hi) { return f2bf(lo) | (f2bf(hi) << 16); }
__device__ __forceinline__ float bf2f(unsigned short b) { return __builtin_bit_cast(float, (unsigned)b << 16); }
__device__ __forceinline__ float wave_sum(float v) {
#pragma unroll
    for (int o = 1; o < 64; o <<= 1) v += __shfl_xor(v, o);
    return v;
}
__device__ __forceinline__ float wave_max(float v) {
#pragma unroll
    for (int o = 1; o < 64; o <<= 1) v = fmaxf(v, __shfl_xor(v, o));
    return v;
}

__device__ __forceinline__ void transpose_item(const float* W, int K, int N, bf16_t* WT, int row_off, const float* g, LAS float* scr, int item, int lane) {
    const int nblk = N / 32, kb = item / nblk, nb = item % nblk, k0 = 64 * kb, n0 = 32 * nb;
#pragma unroll 8
    for (int i = 0; i < 32; ++i) { const int kk = 2 * i + (lane >> 5); float v = W[(size_t)(k0 + kk) * N + n0 + (lane & 31)]; if (g) v *= g[k0 + kk]; scr[kk * 33 + (lane & 31)] = v; }
    asm volatile("s_waitcnt lgkmcnt(0)" ::: "memory");
    const int c = lane & 7;
#pragma unroll
    for (int j = 0; j < 4; ++j) { const int n = (lane >> 3) + 8 * j; const LAS float* s = scr + (8 * c) * 33 + n;
        u32x4 o; o.x = pk2(s[0 * 33], s[1 * 33]); o.y = pk2(s[2 * 33], s[3 * 33]); o.z = pk2(s[4 * 33], s[5 * 33]); o.w = pk2(s[6 * 33], s[7 * 33]);
        *(u32x4*)(WT + (size_t)(row_off + n0 + n) * K + k0 + 8 * c) = o; }
    asm volatile("s_waitcnt lgkmcnt(0)" ::: "memory");
}
__device__ __forceinline__ void sincos_d(double x, float& s, float& c) {
    const double k = __builtin_rint(x * 0.63661977236758134308);
    double r = __builtin_fma(-k, 1.57079632679489655800e+00, x); r = __builtin_fma(-k, 6.12323399573676603587e-17, r);
    const double r2 = r * r;
    double sp = -1.0 / 1307674368000.0; sp = sp * r2 + 1.0 / 6227020800.0; sp = sp * r2 - 1.0 / 39916800.0; sp = sp * r2 + 1.0 / 362880.0; sp = sp * r2 - 1.0 / 5040.0; sp = sp * r2 + 1.0 / 120.0; sp = sp * r2 - 1.0 / 6.0; sp = sp * r2 + 1.0;
    const double sn = sp * r;
    double cp = 1.0 / 20922789888000.0; cp = cp * r2 - 1.0 / 87178291200.0; cp = cp * r2 + 1.0 / 479001600.0; cp = cp * r2 - 1.0 / 3628800.0; cp = cp * r2 + 1.0 / 40320.0; cp = cp * r2 - 1.0 / 720.0; cp = cp * r2 + 1.0 / 24.0; cp = cp * r2 - 0.5; cp = cp * r2 + 1.0;
    const int q = ((int)k) & 3;
    const double ss = (q == 0) ? sn : (q == 1) ? cp : (q == 2) ? -sn : -cp;
    const double cc = (q == 0) ? cp : (q == 1) ? -sn : (q == 2) ? -cp : sn;
    s = (float)ss; c = (float)cc;
}
struct PrepArgs { const float *x, *p, *w_in, *gn_a, *gn_b, *w_o, *w1, *w2, *w_ple, *w_gate; const int* pos; unsigned char* ws; };
__device__ __forceinline__ void prep_phase(const PrepArgs& a, LAS unsigned char* lds, int vb, int nvb) {
    const int tid = threadIdx.x, lane = tid & 63, wave = tid >> 6;
    LAS float* scr = (LAS float*)(lds + wave * 16384);
    const int gw = vb * 8 + wave, ngw = nvb * 8;
    bf16_t* WinT = (bf16_t*)(a.ws + WS_WINT); bf16_t* WoT = (bf16_t*)(a.ws + WS_WOT); bf16_t* W13T = (bf16_t*)(a.ws + WS_W13T);
    bf16_t* W2T = (bf16_t*)(a.ws + WS_W2T); bf16_t* WpT = (bf16_t*)(a.ws + WS_WPT);
    constexpr int I_IN = (DM / 64) * (DIN / 32), I_O = (DM / 64) * (DM / 32), I_1 = (DM / 64) * (DFF / 32), I_G = I_O, I_2 = (DFF / 64) * (DM / 32), I_P = (PLE / 64) * (DM / 32);
    constexpr int NITEMS = I_IN + I_O + I_1 + I_G + I_2 + I_P;
    for (int it = gw; it < NITEMS; it += ngw) {
        int r = it;
        if (r < I_IN) { transpose_item(a.w_in, DM, DIN, WinT, 0, nullptr, scr, r, lane); continue; } r -= I_IN;
        if (r < I_O) { const int kb = r / (DM / 32);
            transpose_item(a.w_o, DM, DM, WoT, 0, (kb < 16) ? a.gn_a : (a.gn_b - 1024), scr, r, lane); continue; } r -= I_O;
        if (r < I_1) { transpose_item(a.w1, DM, DFF, W13T, 0, nullptr, scr, r, lane); continue; } r -= I_1;
        if (r < I_G) { transpose_item(a.w_gate, DM, DM, W13T, DFF, nullptr, scr, r, lane); continue; } r -= I_G;
        if (r < I_2) { transpose_item(a.w2, DFF, DM, W2T, 0, nullptr, scr, r, lane); continue; } r -= I_2;
        transpose_item(a.w_ple, PLE, DM, WpT, 0, nullptr, scr, r, lane);
    }
    bf16_t* XB = (bf16_t*)(a.ws + WS_XB); bf16_t* PB = (bf16_t*)(a.ws + WS_PB);
    const size_t gt = (size_t)vb * 512 + tid, ngt = (size_t)nvb * 512;
    for (size_t i = gt; i < (size_t)M * DM / 8; i += ngt) { const f32x4 v0 = ((const f32x4*)a.x)[2 * i], v1 = ((const f32x4*)a.x)[2 * i + 1];
        u32x4 o; o.x = pk2(v0.x, v0.y); o.y = pk2(v0.z, v0.w); o.z = pk2(v1.x, v1.y); o.w = pk2(v1.z, v1.w); ((u32x4*)XB)[i] = o; }
    for (size_t i = gt; i < (size_t)M * PLE / 8; i += ngt) { const f32x4 v0 = ((const f32x4*)a.p)[2 * i], v1 = ((const f32x4*)a.p)[2 * i + 1];
        u32x4 o; o.x = pk2(v0.x, v0.y); o.y = pk2(v0.z, v0.w); o.z = pk2(v1.x, v1.y); o.w = pk2(v1.z, v1.w); ((u32x4*)PB)[i] = o; }
    float* rope = (float*)(a.ws + WS_ROPE);
    for (size_t i = gt; i < (size_t)M * 16; i += ngt) { const int m = (int)(i >> 4), j = (int)(i & 15);
        const double invf = ::exp2(-(double)j * (1.0 / 16.0) * 18.931568569324174);
        float s, c; sincos_d((double)a.pos[m] * invf, s, c); rope[(size_t)m * 32 + j] = c; rope[(size_t)m * 32 + 16 + j] = s; }
}
namespace g8 {
constexpr int BM = 256, BK = 64, HALF = 128, HTB = HALF * BK * 2;
__device__ __forceinline__ int lds_byte(int r, int c) { const int st = (r >> 4) * 2 + (c >> 5), rr = r & 15, cc = c & 31, ob = rr * 64 + cc * 2; return st * 1024 + (ob ^ (((ob >> 9) & 1) << 5)); }
__device__ __forceinline__ int perm32(int rho) { const int n = rho >> 4, i = rho & 15; return 8 * (i >> 2) + 4 * n + (i & 3); }
struct Unit { int pm, pn; };
struct Seg { const bf16_t* A; const bf16_t* Bt; int lda, ldb, K; };
#define G8_SA(b, h) (((b) * 2 + (h)) * g8::HTB)
#define G8_SB(b, h) ((4 + (b) * 2 + (h)) * g8::HTB)

template <class Epi>
__device__ __forceinline__ void gemm_simple(LAS unsigned char* lds, const Seg s0, const Seg s1, int nM, int nN, const Epi& E, int vb, int nvb) {
    const int tid = threadIdx.x, wid = __builtin_amdgcn_readfirstlane(tid >> 6), lane = tid & 63, wr = wid >> 2, wc = wid & 3, fr = lane & 15, fq = lane >> 4;
    const int aoff = lds_byte(wr * 64 + fr, fq * 8), boff = lds_byte(wc * 32 + fr, fq * 8);
    for (int unit = vb; unit < nM * nN; unit += nvb) {
        Unit u; u.pm = unit / nN; u.pn = unit % nN;
        f32x4 acc[2][2][4][2];
#pragma unroll
        for (int a = 0; a < 2; ++a)
#pragma unroll
            for (int b = 0; b < 2; ++b)
#pragma unroll
                for (int m = 0; m < 4; ++m)
#pragma unroll
                    for (int n = 0; n < 2; ++n) acc[a][b][m][n] = (f32x4){0.f, 0.f, 0.f, 0.f};
        for (int sg = 0; sg < 2; ++sg) {
            const Seg s = sg == 0 ? s0 : s1;
            if (s.K == 0) continue;
            for (int kt = 0; kt < s.K / BK; ++kt) {
                __syncthreads();
#pragma unroll
                for (int i = 0; i < 4; ++i) {
                    const int q = tid + 512 * i, r256 = q >> 3, c8 = q & 7, h = r256 >> 7, r = r256 & 127;
                    const u32x4 va = *(const u32x4*)(s.A + (size_t)(u.pm * BM + r256) * s.lda + kt * BK + c8 * 8);
                    *(LAS u32x4*)(lds + G8_SA(0, h) + lds_byte(r, c8 * 8)) = va;
                    const int rb = Epi::PERM ? ((r & ~31) + perm32(r & 31)) : r;
                    const u32x4 vbv = *(const u32x4*)(s.Bt + (size_t)(u.pn * BM + h * HALF + rb) * s.ldb + kt * BK + c8 * 8);
                    *(LAS u32x4*)(lds + G8_SB(0, h) + lds_byte(r, c8 * 8)) = vbv;
                }
                __syncthreads();
                bf16x8 At[4][2], B0[2][2], B1[2][2];
#pragma unroll
                for (int n = 0; n < 2; ++n)
#pragma unroll
                    for (int k = 0; k < 2; ++k) { B0[n][k] = *(const LAS bf16x8*)(lds + G8_SB(0, 0) + boff + n * 2048 + k * 1024); B1[n][k] = *(const LAS bf16x8*)(lds + G8_SB(0, 1) + boff + n * 2048 + k * 1024); }
#pragma unroll
                for (int ai = 0; ai < 2; ++ai) {
#pragma unroll
                    for (int m = 0; m < 4; ++m)
#pragma unroll
                        for (int k = 0; k < 2; ++k) At[m][k] = *(const LAS bf16x8*)(lds + G8_SA(0, ai) + aoff + m * 2048 + k * 1024);
#pragma unroll
                    for (int m = 0; m < 4; ++m)
#pragma unroll
                        for (int n = 0; n < 2; ++n)
#pragma unroll
                            for (int k = 0; k < 2; ++k) {
                                acc[ai][0][m][n] = __builtin_amdgcn_mfma_f32_16x16x32_bf16(B0[n][k], At[m][k], acc[ai][0][m][n], 0, 0, 0);
                                acc[ai][1][m][n] = __builtin_amdgcn_mfma_f32_16x16x32_bf16(B1[n][k], At[m][k], acc[ai][1][m][n], 0, 0, 0);
                            }
                }
            }
            if (sg == 0 && s1.K != 0) E.mid(acc, u, wr, wc, fr, fq);
        }
        E(acc, u, wr, wc, fr, fq);
    }
}
}

struct Epi1 {
    static constexpr bool PERM = true;
    bf16_t* O; const float* rope;
    __device__ __forceinline__ void mid(f32x4 (&)[2][2][4][2], const g8::Unit&, int, int, int, int) const {}
    __device__ __forceinline__ void operator()(const f32x4 (&acc)[2][2][4][2], const g8::Unit& u, int wr, int wc, int fr, int fq) const {
        const int row0 = u.pm * 256 + wr * 64 + fr, col0 = u.pn * 256 + wc * 32 + 8 * fq;
        const float sgn = fq < 2 ? -1.f : 1.f;
#pragma unroll
        for (int ai = 0; ai < 2; ++ai)
#pragma unroll
            for (int m = 0; m < 4; ++m) {
                const int row = row0 + ai * 128 + m * 16;
                const float* rp = rope + (size_t)row * 32 + 8 * (fq & 1);
                const f32x4 c0 = *(const f32x4*)(rp), c1 = *(const f32x4*)(rp + 4), s0 = *(const f32x4*)(rp + 16), s1 = *(const f32x4*)(rp + 20);
#pragma unroll
                for (int bj = 0; bj < 2; ++bj) {
                    const int hh = 2 * u.pn + bj;
                    const bool is_rope = (wc == 0) && (hh < 10 || (hh >= 12 && hh < 28));
                    f32x4 v0 = acc[ai][bj][m][0], v1 = acc[ai][bj][m][1];
                    if (is_rope) {
                        f32x4 o0, o1;
#pragma unroll
                        for (int j = 0; j < 4; ++j) { o0[j] = __shfl_xor(v0[j], 32); o1[j] = __shfl_xor(v1[j], 32); }
                        v0 = v0 * c0 + (o0 * s0) * sgn; v1 = v1 * c1 + (o1 * s1) * sgn;
                    }
                    u32x4 w; w.x = pk2(v0[0], v0[1]); w.y = pk2(v0[2], v0[3]); w.z = pk2(v1[0], v1[1]); w.w = pk2(v1[2], v1[3]);
                    *(u32x4*)(O + (size_t)row * DIN + col0 + bj * 128) = w;
                }
            }
    }
};
struct Epi2 {
    static constexpr bool PERM = false;
    const float* x; float* V; const float* ssq;
    __device__ __forceinline__ void scales(int row, float& ra, float& rb) const {
        const f32x4* sp = (const f32x4*)(ssq + (size_t)row * 16);
        const f32x4 a0 = sp[0], a1 = sp[1], b0 = sp[2], b1 = sp[3];
        const float sa = (a0[0] + a0[1]) + (a0[2] + a0[3]) + (a1[0] + a1[1]) + (a1[2] + a1[3]);
        const float sb = (b0[0] + b0[1]) + (b0[2] + b0[3]) + (b1[0] + b1[1]) + (b1[2] + b1[3]);
        ra = 1.0f / sqrtf(sa * (1.0f / 1024.0f) + RMS_EPS); rb = 1.0f / sqrtf(sb * (1.0f / 1024.0f) + RMS_EPS);
    }
    __device__ __forceinline__ void mid(f32x4 (&acc)[2][2][4][2], const g8::Unit& u, int wr, int wc, int fr, int fq) const {
#pragma unroll
        for (int ai = 0; ai < 2; ++ai)
#pragma unroll
            for (int m = 0; m < 4; ++m) { float ra, rb; scales(u.pm * 256 + ai * 128 + wr * 64 + m * 16 + fr, ra, rb); const float f = ra / rb;
#pragma unroll
                for (int bj = 0; bj < 2; ++bj)
#pragma unroll
                    for (int n = 0; n < 2; ++n) acc[ai][bj][m][n] = acc[ai][bj][m][n] * f; }
    }
    __device__ __forceinline__ void operator()(const f32x4 (&acc)[2][2][4][2], const g8::Unit& u, int wr, int wc, int fr, int fq) const {
        const int col0 = u.pn * 256 + wc * 32 + 4 * fq;
#pragma unroll
        for (int ai = 0; ai < 2; ++ai)
#pragma unroll
            for (int m = 0; m < 4; ++m) { const int row = u.pm * 256 + ai * 128 + wr * 64 + m * 16 + fr; float ra, rb; scales(row, ra, rb);
#pragma unroll
                for (int bj = 0; bj < 2; ++bj)
#pragma unroll
                    for (int n = 0; n < 2; ++n) { const size_t off = (size_t)row * DM + col0 + bj * 128 + n * 16;
                        const f32x4 xv = *(const f32x4*)(x + off); *(f32x4*)(V + off) = xv * ALPHA + acc[ai][bj][m][n] * rb; } }
    }
};
struct Epi3 {
    static constexpr bool PERM = true;
    bf16_t* HID; bf16_t* GATE;
    __device__ __forceinline__ void mid(f32x4 (&)[2][2][4][2], const g8::Unit&, int, int, int, int) const {}
    __device__ __forceinline__ void operator()(const f32x4 (&acc)[2][2][4][2], const g8::Unit& u, int wr, int wc, int fr, int fq) const {
        const bool is_gate = u.pn >= DFF / 256;
        bf16_t* base = is_gate ? GATE : HID; const int ldc = is_gate ? DM : DFF; const int colt = (is_gate ? u.pn - DFF / 256 : u.pn) * 256;
        const int row0 = u.pm * 256 + wr * 64 + fr, col0 = colt + wc * 32 + 8 * fq;
#pragma unroll
        for (int ai = 0; ai < 2; ++ai)
#pragma unroll
            for (int m = 0; m < 4; ++m)
#pragma unroll
                for (int bj = 0; bj < 2; ++bj) { f32x4 v0 = acc[ai][bj][m][0], v1 = acc[ai][bj][m][1];
                    if (is_gate) {
#pragma unroll
                        for (int j = 0; j < 4; ++j) { v0[j] = 1.0f / (1.0f + __expf(-v0[j])); v1[j] = 1.0f / (1.0f + __expf(-v1[j])); }
                    } else {
#pragma unroll
                        for (int j = 0; j < 4; ++j) { const float a = fmaxf(v0[j], 0.f), b = fmaxf(v1[j], 0.f); v0[j] = a * a; v1[j] = b * b; }
                    }
                    u32x4 w; w.x = pk2(v0[0], v0[1]); w.y = pk2(v0[2], v0[3]); w.z = pk2(v1[0], v1[1]); w.w = pk2(v1[2], v1[3]);
                    *(u32x4*)(base + (size_t)(row0 + ai * 128 + m * 16) * ldc + col0 + bj * 128) = w; }
    }
};
struct Epi4 {
    static constexpr bool PERM = false;
    const bf16_t* GATE; float* H;
    __device__ __forceinline__ void mid(f32x4 (&acc)[2][2][4][2], const g8::Unit& u, int wr, int wc, int fr, int fq) const {
        const int col0 = u.pn * 256 + wc * 32 + 4 * fq;
#pragma unroll
        for (int ai = 0; ai < 2; ++ai)
#pragma unroll
            for (int m = 0; m < 4; ++m) { const int row = u.pm * 256 + ai * 128 + wr * 64 + m * 16 + fr;
#pragma unroll
                for (int bj = 0; bj < 2; ++bj)
#pragma unroll
                    for (int n = 0; n < 2; ++n) { const u32x2 g = *(const u32x2*)(GATE + (size_t)row * DM + col0 + bj * 128 + n * 16);
                        f32x4 gv; gv[0] = bf2f((unsigned short)(g.x & 0xffff)); gv[1] = bf2f((unsigned short)(g.x >> 16)); gv[2] = bf2f((unsigned short)(g.y & 0xffff)); gv[3] = bf2f((unsigned short)(g.y >> 16));
                        acc[ai][bj][m][n] = acc[ai][bj][m][n] * gv; } }
    }
    __device__ __forceinline__ void operator()(const f32x4 (&acc)[2][2][4][2], const g8::Unit& u, int wr, int wc, int fr, int fq) const {
        const int col0 = u.pn * 256 + wc * 32 + 4 * fq;
#pragma unroll
        for (int ai = 0; ai < 2; ++ai)
#pragma unroll
            for (int m = 0; m < 4; ++m) { const int row = u.pm * 256 + ai * 128 + wr * 64 + m * 16 + fr;
#pragma unroll
                for (int bj = 0; bj < 2; ++bj)
#pragma unroll
                    for (int n = 0; n < 2; ++n) { const size_t off = (size_t)row * DM + col0 + bj * 128 + n * 16;
                        const f32x4 hv = *(const f32x4*)(H + off); *(f32x4*)(H + off) = hv * ALPHA + acc[ai][bj][m][n]; } }
    }
};

__device__ __forceinline__ void ln_rows(float* V, bf16_t* OB, const float* g, const float* b, int vb, int nvb) {
    const int tid = threadIdx.x, lane = tid & 63, wave = tid >> 6;
    for (int row = vb * 8 + wave; row < M; row += nvb * 8) {
        f32x4* vr = (f32x4*)(V + (size_t)row * DM) + lane;
        f32x4 v[8]; float s = 0.f;
#pragma unroll
        for (int j = 0; j < 8; ++j) { v[j] = vr[64 * j]; s += (v[j][0] + v[j][1]) + (v[j][2] + v[j][3]); }
        const float mean = wave_sum(s) * (1.0f / DM); float s2 = 0.f;
#pragma unroll
        for (int j = 0; j < 8; ++j) { v[j] = v[j] - mean; s2 += (v[j][0] * v[j][0] + v[j][1] * v[j][1]) + (v[j][2] * v[j][2] + v[j][3] * v[j][3]); }
        const float rstd = 1.0f / sqrtf(wave_sum(s2) * (1.0f / DM) + LN_EPS);
#pragma unroll
        for (int j = 0; j < 8; ++j) { const f32x4 gg = ((const f32x4*)g)[lane + 64 * j], bb = ((const f32x4*)b)[lane + 64 * j];
            const f32x4 o = v[j] * rstd * gg + bb; vr[64 * j] = o;
            if (OB) { u32x2 w; w.x = pk2(o[0], o[1]); w.y = pk2(o[2], o[3]); *((u32x2*)(OB + (size_t)row * DM) + lane + 64 * j) = w; } }
    }
}

__device__ __forceinline__ float dot128(const bf16x8 (&q)[16], const bf16_t* kp) {
    float d = 0.f;
#pragma unroll
    for (int i = 0; i < 16; ++i) { const bf16x8 kv = *(const bf16x8*)(kp + 8 * i);
#pragma unroll
        for (int j = 0; j < 8; ++j) d += bf2f((unsigned short)q[i][j]) * bf2f((unsigned short)kv[j]); }
    return d;
}
__device__ __forceinline__ void attn_naive(const bf16_t* proj, const float* sink, bf16_t* ocat, float* ssq, int vb, int nvb) {
    const int tid = threadIdx.x, lane = tid & 63, wave = tid >> 6;
    for (int item = vb * 8 + wave; item < M * 16; item += nvb * 8) {
        const int m = item >> 4, hs = item & 15, b = m / SEQ, s = m % SEQ;
        const bool isA = hs < 8; const int h = hs & 7;
        const int qc = isA ? C_QA + h * HD : C_QB + h * HD, kc = isA ? C_KA + (h >> 2) * HD : C_KB + h * HD, vc = isA ? C_VA + (h >> 2) * HD : C_VB + h * HD;
        bf16x8 q[16];
#pragma unroll
        for (int i = 0; i < 16; ++i) q[i] = *(const bf16x8*)(proj + (size_t)m * DIN + qc + 8 * i);
        const bf16_t* kb = proj + (size_t)b * SEQ * DIN + kc; const bf16_t* vbp = proj + (size_t)b * SEQ * DIN + vc;
        float sc[9]; int kn[9]; float mx = -1e30f;
        if (isA) {
#pragma unroll
            for (int i = 0; i < 9; ++i) { const int n = s - 128 + lane + 64 * i; const bool ok = (i < 5) && n >= 0 && n < SEQ && n <= s + 128;
                kn[i] = ok ? n : -1; sc[i] = ok ? dot128(q, kb + (size_t)n * DIN) * SM_SCALE : -1e30f; mx = fmaxf(mx, sc[i]); }
        } else {
#pragma unroll
            for (int i = 0; i < 9; ++i) { const int pi = i / 3, r = (pi == 0) ? 1 : (pi == 1) ? 4 : 16; const int j = lane - 64 + 64 * (i % 3); const int n = s + r * j; const bool ok = j <= 64 && n >= 0 && n < SEQ;
                kn[i] = ok ? n : -1; sc[i] = ok ? dot128(q, kb + (size_t)n * DIN) * SM_SCALE : -1e30f; mx = fmaxf(mx, sc[i]); }
        }
        mx = wave_max(mx); const float sk = isA ? sink[h] : -1e30f; mx = fmaxf(mx, sk);
        float den = 0.f; float pr[9];
#pragma unroll
        for (int i = 0; i < 9; ++i) { pr[i] = kn[i] >= 0 ? __expf(sc[i] - mx) : 0.f; den += pr[i]; }
        den = wave_sum(den) + (isA ? __expf(sk - mx) : 0.f);
        float o0 = 0.f, o1 = 0.f;
#pragma unroll
        for (int i = 0; i < 9; ++i) {
            if (isA && i >= 5) continue;
            for (int l = 0; l < 64; ++l) { const float pv = __shfl(pr[i], l); const int n = __shfl(kn[i], l);
                if (n >= 0) { const unsigned vv = *(const unsigned*)(vbp + (size_t)n * DIN + 2 * lane); o0 += pv * bf2f((unsigned short)(vv & 0xffff)); o1 += pv * bf2f((unsigned short)(vv >> 16)); } }
        }
        const float inv = 1.0f / den; o0 *= inv; o1 *= inv;
        *(unsigned*)(ocat + (size_t)m * DM + hs * HD + 2 * lane) = pk2(o0, o1);
        const float q2 = wave_sum(o0 * o0 + o1 * o1);
        if (lane == 0) ssq[(size_t)m * 16 + hs] = q2;
    }
}

struct Args { const float* in[16]; float* out; unsigned char* ws; };
__device__ __forceinline__ PrepArgs mk_prep(const Args& a) { PrepArgs p; p.x = a.in[0]; p.p = a.in[1]; p.pos = (const int*)a.in[2]; p.w_in = a.in[3]; p.gn_a = a.in[5]; p.gn_b = a.in[6]; p.w_o = a.in[7];
    p.w1 = a.in[10]; p.w2 = a.in[11]; p.w_ple = a.in[12]; p.w_gate = a.in[13]; p.ws = a.ws; return p; }
extern __shared__ __attribute__((aligned(16))) unsigned char dyn_lds[];
__global__ void __launch_bounds__(512) k_mega(Args a) {
    cg::grid_group grid = cg::this_grid();
    LAS unsigned char* lds = (LAS unsigned char*)dyn_lds;
    const int vb = blockIdx.x, nvb = gridDim.x;
    { const PrepArgs p = mk_prep(a); prep_phase(p, lds, vb, nvb); }
    grid.sync();
    { g8::Seg s0{(const bf16_t*)(a.ws + WS_XB), (const bf16_t*)(a.ws + WS_WINT), DM, DM, DM}, s1{nullptr, nullptr, 0, 0, 0};
      Epi1 E{(bf16_t*)(a.ws + WS_PROJ), (const float*)(a.ws + WS_ROPE)};
      g8::gemm_simple(lds, s0, s1, M / 256, DIN / 256, E, vb, nvb); }
    grid.sync();
    attn_naive((const bf16_t*)(a.ws + WS_PROJ), a.in[4], (bf16_t*)(a.ws + WS_OCAT), (float*)(a.ws + WS_SSQ), vb, nvb);
    grid.sync();
    { const bf16_t* oc = (const bf16_t*)(a.ws + WS_OCAT); const bf16_t* wo = (const bf16_t*)(a.ws + WS_WOT);
      g8::Seg s0{oc, wo, DM, DM, 1024}, s1{oc + 1024, wo + 1024, DM, DM, 1024};
      Epi2 E{a.in[0], a.out, (const float*)(a.ws + WS_SSQ)};
      g8::gemm_simple(lds, s0, s1, M / 256, DM / 256, E, vb, nvb); }
    grid.sync();
    ln_rows(a.out, (bf16_t*)(a.ws + WS_H1B), a.in[8], a.in[9], vb, nvb);
    grid.sync();
    { g8::Seg s0{(const bf16_t*)(a.ws + WS_H1B), (const bf16_t*)(a.ws + WS_W13T), DM, DM, DM}, s1{nullptr, nullptr, 0, 0, 0};
      Epi3 E{(bf16_t*)(a.ws + WS_HID), (bf16_t*)(a.ws + WS_GATE)};
      g8::gemm_simple(lds, s0, s1, M / 256, N13 / 256, E, vb, nvb); }
    grid.sync();
    { g8::Seg s0{(const bf16_t*)(a.ws + WS_PB), (const bf16_t*)(a.ws + WS_WPT), PLE, PLE, PLE}, s1{(const bf16_t*)(a.ws + WS_HID), (const bf16_t*)(a.ws + WS_W2T), DFF, DFF, DFF};
      Epi4 E{(const bf16_t*)(a.ws + WS_GATE), a.out};
      g8::gemm_simple(lds, s0, s1, M / 256, DM / 256, E, vb, nvb); }
    grid.sync();
    ln_rows(a.out, nullptr, a.in[14], a.in[15], vb, nvb);
}

extern "C" void kernel_launch(void* const* d_in, const int* in_sizes, int n_in, void* d_out, int out_size, void* d_ws, size_t ws_size, hipStream_t stream) {
    if (n_in != 16 || out_size != M * DM || ws_size < WS_END) { fprintf(stderr, "kernel_launch: unexpected shapes (n_in %d out %d ws %zu)\n", n_in, out_size, ws_size); return; }
    constexpr int LDS = 131072;
    static int grid_blocks = 0;
    if (!grid_blocks) {
        int dev = 0, cus = 0, per_cu = 0;
        (void)hipGetDevice(&dev);
        (void)hipDeviceGetAttribute(&cus, hipDeviceAttributeMultiprocessorCount, dev);
        (void)hipFuncSetAttribute((const void*)k_mega, hipFuncAttributeMaxDynamicSharedMemorySize, LDS);
        (void)hipOccupancyMaxActiveBlocksPerMultiprocessor(&per_cu, (const void*)k_mega, 512, LDS);
        if (per_cu < 1) { fprintf(stderr, "kernel_launch: occupancy query says %d blocks/CU\n", per_cu); per_cu = 1; }
        grid_blocks = cus * 1;
        fprintf(stderr, "kernel_launch: cus %d per_cu %d grid %d\n", cus, per_cu, grid_blocks);
    }
    Args a{};
    for (int i = 0; i < 16; ++i) a.in[i] = (const float*)d_in[i];
    a.out = (float*)d_out; a.ws = (unsigned char*)d_ws;
    void* args[] = {&a};
    hipError_t e = hipLaunchCooperativeKernel((const void*)k_mega, dim3(grid_blocks), dim3(512), args, LDS, stream);
    if (e != hipSuccess) fprintf(stderr, "cooperative launch failed: %s (grid %d)\n", hipGetErrorString(e), grid_blocks);
}
```

```cpp
#include <hip/hip_runtime.h>
#include <hip/hip_cooperative_groups.h>
namespace cg = cooperative_groups;
#include <cstdio>
#include <cstdint>

#define LAS __attribute__((address_space(3)))
typedef unsigned short bf16_t;
typedef short bf16x8 __attribute__((ext_vector_type(8)));
typedef float f32x4 __attribute__((ext_vector_type(4)));
typedef float f32x2 __attribute__((ext_vector_type(2)));
typedef unsigned u32x4 __attribute__((ext_vector_type(4)));
typedef unsigned u32x2 __attribute__((ext_vector_type(2)));

constexpr int NB = 8, SEQ = 2048, M = NB * SEQ;
constexpr int DM = 2048, DIN = 4608, DFF = 8192, PLE = 256, HD = 128;
constexpr int N13 = DFF + DM;
constexpr int C_QA = 0, C_KA = 1024, C_VA = 1280, C_QB = 1536, C_KB = 2560, C_VB = 3584;
constexpr float ALPHA = 1.18920711500272f;
constexpr float LN_EPS = 1e-5f, RMS_EPS = 1e-6f;
constexpr float SM_SCALE = 0.08838834764831845f;

constexpr size_t MiB = 1u << 20;
constexpr size_t WS_CTL = 0, WS_ROPE = 1 * MiB, WS_SSQ = 3 * MiB;
constexpr size_t WS_WINT = 6 * MiB, WS_WOT = 24 * MiB, WS_W13T = 32 * MiB, WS_W2T = 72 * MiB  ;
constexpr size_t WS_H1B = 113 * MiB, WS_XB = 113 * MiB  , WS_GATE = 177 * MiB;
constexpr size_t WS_PROJ = 241 * MiB, WS_OCAT = 385 * MiB, WS_HID = 241 * MiB  , WS_END = 505 * MiB;
constexpr int KH = DFF + PLE;

__device__ __forceinline__ unsigned f2bf(float f) { unsigned u = __builtin_bit_cast(unsigned, f); return (u + 0x7fffu + ((u >> 16) & 1u)) >> 16; }
__device__ __forceinline__ unsigned pk2(float lo, float hi) { return f2bf(lo) | (f2bf(hi) << 16); }
__device__ __forceinline__ float bf2f(unsigned short b) { return __builtin_bit_cast(float, (unsigned)b << 16); }
__device__ __forceinline__ float wave_sum(float v) {
#pragma unroll
    for (int o = 1; o < 64; o <<= 1) v += __shfl_xor(v, o);
    return v;
}
__device__ __forceinline__ float wave_max(float v) {
#pragma unroll
    for (int o = 1; o < 64; o <<= 1) v = fmaxf(v, __shfl_xor(v, o));
    return v;
}

__device__ __forceinline__ void transpose_item(const float* W, int N, bf16_t* WT, int ldk, int koff, int row_off, const float* g, LAS float* scr, int item, int lane) {
    const int nblk = N / 32, kb = item / nblk, nb = item % nblk, k0 = 64 * kb, n0 = 32 * nb;
#pragma unroll 8
    for (int i = 0; i < 32; ++i) { const int kk = 2 * i + (lane >> 5); float v = W[(size_t)(k0 + kk) * N + n0 + (lane & 31)]; if (g) v *= g[k0 + kk]; scr[kk * 33 + (lane & 31)] = v; }
    asm volatile("s_waitcnt lgkmcnt(0)" ::: "memory");
    const int c = lane & 7;
#pragma unroll
    for (int j = 0; j < 4; ++j) { const int n = (lane >> 3) + 8 * j; const LAS float* s = scr + (8 * c) * 33 + n;
        u32x4 o; o.x = pk2(s[0 * 33], s[1 * 33]); o.y = pk2(s[2 * 33], s[3 * 33]); o.z = pk2(s[4 * 33], s[5 * 33]); o.w = pk2(s[6 * 33], s[7 * 33]);
        *(u32x4*)(WT + (size_t)(row_off + n0 + n) * ldk + koff + k0 + 8 * c) = o; }
    asm volatile("s_waitcnt lgkmcnt(0)" ::: "memory");
}
__device__ __forceinline__ void sincos_d(double x, float& s, float& c) {
    const double k = __builtin_rint(x * 0.63661977236758134308);
    double r = __builtin_fma(-k, 1.57079632679489655800e+00, x); r = __builtin_fma(-k, 6.12323399573676603587e-17, r);
    const double r2 = r * r;
    double sp = -1.0 / 1307674368000.0; sp = sp * r2 + 1.0 / 6227020800.0; sp = sp * r2 - 1.0 / 39916800.0; sp = sp * r2 + 1.0 / 362880.0; sp = sp * r2 - 1.0 / 5040.0; sp = sp * r2 + 1.0 / 120.0; sp = sp * r2 - 1.0 / 6.0; sp = sp * r2 + 1.0;
    const double sn = sp * r;
    double cp = 1.0 / 20922789888000.0; cp = cp * r2 - 1.0 / 87178291200.0; cp = cp * r2 + 1.0 / 479001600.0; cp = cp * r2 - 1.0 / 3628800.0; cp = cp * r2 + 1.0 / 40320.0; cp = cp * r2 - 1.0 / 720.0; cp = cp * r2 + 1.0 / 24.0; cp = cp * r2 - 0.5; cp = cp * r2 + 1.0;
    const int q = ((int)k) & 3;
    const double ss = (q == 0) ? sn : (q == 1) ? cp : (q == 2) ? -sn : -cp;
    const double cc = (q == 0) ? cp : (q == 1) ? -sn : (q == 2) ? -cp : sn;
    s = (float)ss; c = (float)cc;
}
struct PrepArgs { const float *x, *p, *w_in, *gn_a, *gn_b, *w_o, *w1, *w2, *w_ple, *w_gate; const int* pos; unsigned char* ws; };
__device__ __forceinline__ void prep_phase(const PrepArgs& a, LAS unsigned char* lds, int vb, int nvb) {
    const int tid = threadIdx.x, lane = tid & 63, wave = tid >> 6;
    LAS float* scr = (LAS float*)(lds + wave * 16384);
    const int gw = vb * 8 + wave, ngw = nvb * 8;
    bf16_t* WinT = (bf16_t*)(a.ws + WS_WINT); bf16_t* WoT = (bf16_t*)(a.ws + WS_WOT); bf16_t* W13T = (bf16_t*)(a.ws + WS_W13T); bf16_t* W2T = (bf16_t*)(a.ws + WS_W2T);
    constexpr int I_IN = (DM / 64) * (DIN / 32), I_O = (DM / 64) * (DM / 32), I_1 = (DM / 64) * (DFF / 32), I_G = I_O, I_2 = (DFF / 64) * (DM / 32), I_P = (PLE / 64) * (DM / 32);
    constexpr int NITEMS = I_IN + I_O + I_1 + I_G + I_2 + I_P;
    for (int it = gw; it < NITEMS; it += ngw) {
        int r = it;
        if (r < I_IN) { transpose_item(a.w_in, DIN, WinT, DM, 0, 0, nullptr, scr, r, lane); continue; } r -= I_IN;
        if (r < I_O) { const int kb = r / (DM / 32);
            transpose_item(a.w_o, DM, WoT, DM, 0, 0, (kb < 16) ? a.gn_a : (a.gn_b - 1024), scr, r, lane); continue; } r -= I_O;
        if (r < I_1) { transpose_item(a.w1, DFF, W13T, DM, 0, 0, nullptr, scr, r, lane); continue; } r -= I_1;
        if (r < I_G) { transpose_item(a.w_gate, DM, W13T, DM, 0, DFF, nullptr, scr, r, lane); continue; } r -= I_G;
        if (r < I_2) { transpose_item(a.w2, DM, W2T, KH, 0, 0, nullptr, scr, r, lane); continue; } r -= I_2;
        transpose_item(a.w_ple, DM, W2T, KH, DFF, 0, nullptr, scr, r, lane);
    }
    bf16_t* XB = (bf16_t*)(a.ws + WS_XB);
    const size_t gt = (size_t)vb * 512 + tid, ngt = (size_t)nvb * 512;
    for (size_t i = gt; i < (size_t)M * DM / 8; i += ngt) { const f32x4 v0 = ((const f32x4*)a.x)[2 * i], v1 = ((const f32x4*)a.x)[2 * i + 1];
        u32x4 o; o.x = pk2(v0.x, v0.y); o.y = pk2(v0.z, v0.w); o.z = pk2(v1.x, v1.y); o.w = pk2(v1.z, v1.w); ((u32x4*)XB)[i] = o; }
    float* rope = (float*)(a.ws + WS_ROPE);
    for (size_t i = gt; i < (size_t)M * 16; i += ngt) { const int m = (int)(i >> 4), j = (int)(i & 15);
        const double invf = ::exp2(-(double)j * (1.0 / 16.0) * 18.931568569324174);
        float s, c; sincos_d((double)a.pos[m] * invf, s, c); rope[(size_t)m * 32 + j] = c; rope[(size_t)m * 32 + 16 + j] = s; }
}
__device__ __forceinline__ void p_to_hidp(const float* p, bf16_t* HIDP, int vb, int nvb) {
    const size_t gt = (size_t)vb * 512 + threadIdx.x, ngt = (size_t)nvb * 512;
    for (size_t i = gt; i < (size_t)M * PLE / 8; i += ngt) { const f32x4 v0 = ((const f32x4*)p)[2 * i], v1 = ((const f32x4*)p)[2 * i + 1];
        const size_t row = i / (PLE / 8), c8 = i % (PLE / 8);
        u32x4 o; o.x = pk2(v0.x, v0.y); o.y = pk2(v0.z, v0.w); o.z = pk2(v1.x, v1.y); o.w = pk2(v1.z, v1.w); *(u32x4*)(HIDP + row * KH + DFF + c8 * 8) = o; }
}
namespace g8 {
constexpr int BM = 256, BK = 64, HALF = 128, HTB = HALF * BK * 2  , STAGE_BYTES = 8 * HTB, NXCD = 8, WGM = 8;
__host__ __device__ __forceinline__ int lds_byte(int r, int c) { const int st = (r >> 4) * 2 + (c >> 5), rr = r & 15, cc = c & 31, ob = rr * 64 + cc * 2; return st * 1024 + (ob ^ (((ob >> 9) & 1) << 5)); }
__host__ __device__ __forceinline__ void stage_rc(int b, int& R, int& C) { const int st = b / 1024, sb = b % 1024, swz = sb ^ (((sb >> 9) & 1) << 5); R = (st >> 1) * 16 + swz / 64; C = (st & 1) * 32 + (swz % 64) / 2; }
__host__ __device__ __forceinline__ int perm32(int rho) { const int n = rho >> 4, i = rho & 15; return 8 * (i >> 2) + 4 * n + (i & 3); }
struct Unit { int pm, pn, seg; };
struct Gemm { const bf16_t* A; const bf16_t* Bt; int lda, ldb; int kofs0, kofs1; int nt0, nt1; };
template <int NSEG> struct StepOrder {
    int nM, nN, nwg, G, c;
    __device__ void init(int M_, int N_, int G_, int c_) { nM = M_ / BM; nN = N_ / BM; nwg = nM * nN; G = G_; c = c_; }
    __device__ __forceinline__ bool next(int i, Unit& u) const {
        const int ui = (NSEG == 2) ? (i >> 1) : i; u.seg = (NSEG == 2) ? (i & 1) : 0;
        const long L = (long)ui * G + c; if (L >= nwg) return false;
        int wgid = (int)L; { const int q = nwg / NXCD, r = nwg % NXCD, xcd = wgid % NXCD, off = wgid / NXCD; wgid = (xcd < r ? xcd * (q + 1) : r * (q + 1) + (xcd - r) * q) + off; }
        const int nig = WGM * nN, gid = wgid / nig, fm = gid * WGM, gsz = (nM - fm) < WGM ? (nM - fm) : WGM;
        u.pm = fm + ((wgid % nig) % gsz); u.pn = (wgid % nig) / gsz; return true;
    }
};
template <class Epi, int NSEG, bool ALIGN_EPI>
__device__ __forceinline__ void gemm_phase(LAS unsigned char* lds, const Gemm g, const StepOrder<NSEG>& S, const Epi& E) {
    const int tid = threadIdx.x, wid = __builtin_amdgcn_readfirstlane(tid >> 6), lane = tid & 63, wr = wid >> 2, wc = wid & 3, fr = lane & 15, fq = lane >> 4;
    unsigned voffA[2], voffB[2];
#pragma unroll
    for (int i = 0; i < 2; ++i) { int R, C; stage_rc(tid * 16 + i * 8192, R, C); const int Rb = Epi::PERM ? ((R & ~31) + perm32(R & 31)) : R;
        voffA[i] = (unsigned)(R * g.lda + C) * 2u; voffB[i] = (unsigned)(Rb * g.ldb + C) * 2u; }
    const size_t kstep = (size_t)(BK * 2);
    const size_t hstepA = (size_t)HALF * g.lda * 2, hstepB = (size_t)HALF * g.ldb * 2, tstepA = 2 * hstepA, tstepB = 2 * hstepB;
    const unsigned ldsw = (unsigned)wid * 1024u;
    const int aoff = lds_byte(wr * 64 + fr, fq * 8), boff = lds_byte(wc * 32 + fr, fq * 8);
#define PG8_SA(b, h) (((b) * 2 + (h)) * g8::HTB)
#define PG8_SB(b, h) ((4 + (b) * 2 + (h)) * g8::HTB)
#define PG8_STAGE(bufoff, gbase, voff) do { _Pragma("unroll") for (int _i = 0; _i < 2; ++_i) \
        __builtin_amdgcn_global_load_lds((const unsigned*)((const char*)(gbase) + (voff)[_i]), (LAS unsigned*)(lds + (bufoff) + ldsw + _i * 8192), 16, 0, 0); } while (0)
#define PG8_LDA(dst, b, h) do { _Pragma("unroll") for (int m = 0; m < 4; ++m) _Pragma("unroll") for (int k = 0; k < 2; ++k) dst[m][k] = *(const LAS bf16x8*)(lds + PG8_SA(b, h) + aoff + m * 2048 + k * 1024); } while (0)
#define PG8_LDB(dst, b, h) do { _Pragma("unroll") for (int n = 0; n < 2; ++n) _Pragma("unroll") for (int k = 0; k < 2; ++k) dst[n][k] = *(const LAS bf16x8*)(lds + PG8_SB(b, h) + boff + n * 2048 + k * 1024); } while (0)
#define PG8_MMA(ai, bj, At, Bt) do { __builtin_amdgcn_s_setprio(1); _Pragma("unroll") for (int m = 0; m < 4; ++m) _Pragma("unroll") for (int n = 0; n < 2; ++n) _Pragma("unroll") for (int k = 0; k < 2; ++k) \
        acc[ai][bj][m][n] = __builtin_amdgcn_mfma_f32_16x16x32_bf16(Bt[n][k], At[m][k], acc[ai][bj][m][n], 0, 0, 0); __builtin_amdgcn_s_setprio(0); } while (0)
#define PG8_WAIT_V(n) asm volatile("s_waitcnt vmcnt(" #n ")" ::: "memory")
#define PG8_WAIT_L(n) asm volatile("s_waitcnt lgkmcnt(" #n ")" ::: "memory")
#define PG8_BAR __builtin_amdgcn_s_barrier()
#define PG8_SCHED __builtin_amdgcn_sched_barrier(0)
#define PG8_BASEA(u) ((const char*)g.A + (size_t)(u).pm * tstepA + (size_t)((u).seg ? g.kofs1 : g.kofs0) * 2)
#define PG8_BASEB(u) ((const char*)g.Bt + (size_t)(u).pn * tstepB + (size_t)((u).seg ? g.kofs1 : g.kofs0) * 2)
    Unit cur, nxt; int ui = 0;
    if (!S.next(0, cur)) return;
    f32x4 acc[2][2][4][2];
#pragma unroll
    for (int a = 0; a < 2; ++a)
#pragma unroll
        for (int b = 0; b < 2; ++b)
#pragma unroll
            for (int m = 0; m < 4; ++m)
#pragma unroll
                for (int n = 0; n < 2; ++n) acc[a][b][m][n] = (f32x4){0.f, 0.f, 0.f, 0.f};
    bf16x8 At[4][2], B0[2][2], B1[2][2];
    const char* cA = PG8_BASEA(cur); const char* cB = PG8_BASEB(cur);
    PG8_STAGE(PG8_SB(0, 0), cB, voffB); PG8_STAGE(PG8_SB(0, 1), cB + hstepB, voffB); PG8_STAGE(PG8_SA(0, 0), cA, voffA); PG8_STAGE(PG8_SA(0, 1), cA + hstepA, voffA);
    if (wr == 1) PG8_BAR;
    PG8_WAIT_V(2); PG8_BAR;
    PG8_STAGE(PG8_SB(1, 0), cB + kstep, voffB); PG8_STAGE(PG8_SA(1, 0), cA + kstep, voffA); PG8_STAGE(PG8_SB(1, 1), cB + hstepB + kstep, voffB);
    PG8_WAIT_V(6); PG8_BAR;
    for (;;) {
        const bool has_next = S.next(ui + 1, nxt);
        const char* nA = has_next ? PG8_BASEA(nxt) : cA; const char* nB = has_next ? PG8_BASEB(nxt) : cB;
        const int nt = cur.seg ? g.nt1 : g.nt0;
        for (int t = 0; t < nt; t += 2) {
            const bool last = (t == nt - 2);
            const char* a1 = cA + (size_t)(t + 1) * kstep;
            const char* a2 = last ? nA : cA + (size_t)(t + 2) * kstep; const char* b2 = last ? nB : cB + (size_t)(t + 2) * kstep;
            const char* a3 = a2 + kstep; const char* b3 = b2 + kstep;
            PG8_LDB(B0, 0, 0); PG8_LDB(B1, 0, 1); PG8_SCHED; PG8_LDA(At, 0, 0); PG8_STAGE(PG8_SA(1, 1), a1 + hstepA, voffA);
            PG8_WAIT_V(8); PG8_WAIT_L(0); PG8_BAR; PG8_MMA(0, 0, At, B0); PG8_MMA(0, 1, At, B1); PG8_BAR; PG8_SCHED;
            PG8_LDA(At, 0, 1); PG8_STAGE(PG8_SB(0, 0), b2, voffB); PG8_STAGE(PG8_SB(0, 1), b2 + hstepB, voffB); PG8_STAGE(PG8_SA(0, 0), a2, voffA);
            PG8_WAIT_V(8); PG8_WAIT_L(0); PG8_BAR; PG8_MMA(1, 0, At, B0); PG8_MMA(1, 1, At, B1); PG8_BAR; PG8_SCHED;
            PG8_LDB(B0, 1, 0); PG8_LDB(B1, 1, 1); PG8_SCHED; PG8_LDA(At, 1, 0); PG8_STAGE(PG8_SA(0, 1), a2 + hstepA, voffA);
            PG8_WAIT_V(8); PG8_WAIT_L(0); PG8_BAR; PG8_MMA(0, 0, At, B0); PG8_MMA(0, 1, At, B1); PG8_BAR; PG8_SCHED;
            PG8_LDA(At, 1, 1); PG8_STAGE(PG8_SB(1, 0), b3, voffB); PG8_STAGE(PG8_SB(1, 1), b3 + hstepB, voffB); PG8_STAGE(PG8_SA(1, 0), a3, voffA);
            PG8_WAIT_V(8); PG8_WAIT_L(0); PG8_BAR; PG8_MMA(1, 0, At, B0); PG8_MMA(1, 1, At, B1); PG8_BAR; PG8_SCHED;
        }
        if constexpr (ALIGN_EPI) { if (wr == 0) PG8_BAR; }
        const bool fin = (NSEG == 1) || (cur.seg == NSEG - 1);
        if (fin) E(acc, cur, wr, wc, fr, fq); else E.mid(acc, cur, wr, wc, fr, fq);
        if (!has_next) break;
        if (fin) {
#pragma unroll
            for (int a = 0; a < 2; ++a)
#pragma unroll
                for (int b = 0; b < 2; ++b)
#pragma unroll
                    for (int m = 0; m < 4; ++m)
#pragma unroll
                        for (int n = 0; n < 2; ++n) acc[a][b][m][n] = (f32x4){0.f, 0.f, 0.f, 0.f};
        }
        cur = nxt; cA = nA; cB = nB; ++ui;
        if constexpr (ALIGN_EPI) { if (wr == 1) PG8_BAR; }
    }
    PG8_WAIT_V(0);
    if constexpr (!ALIGN_EPI) { if (wr == 0) PG8_BAR; }
    PG8_BAR;
#undef PG8_SA
#undef PG8_SB
#undef PG8_STAGE
#undef PG8_LDA
#undef PG8_LDB
#undef PG8_MMA
#undef PG8_WAIT_V
#undef PG8_WAIT_L
#undef PG8_BAR
#undef PG8_SCHED
#undef PG8_BASEA
#undef PG8_BASEB
}
}

struct Epi1 {
    static constexpr bool PERM = true;
    bf16_t* O; const float* rope;
    __device__ __forceinline__ void mid(f32x4 (&)[2][2][4][2], const g8::Unit&, int, int, int, int) const {}
    __device__ __forceinline__ void operator()(const f32x4 (&acc)[2][2][4][2], const g8::Unit& u, int wr, int wc, int fr, int fq) const {
        const int row0 = u.pm * 256 + wr * 64 + fr, col0 = u.pn * 256 + wc * 32 + 8 * fq;
        const float sgn = fq < 2 ? -1.f : 1.f;
#pragma unroll
        for (int ai = 0; ai < 2; ++ai)
#pragma unroll
            for (int m = 0; m < 4; ++m) {
                const int row = row0 + ai * 128 + m * 16;
                const float* rp = rope + (size_t)row * 32 + 8 * (fq & 1);
                const f32x4 c0 = *(const f32x4*)(rp), c1 = *(const f32x4*)(rp + 4), s0 = *(const f32x4*)(rp + 16), s1 = *(const f32x4*)(rp + 20);
#pragma unroll
                for (int bj = 0; bj < 2; ++bj) {
                    const int hh = 2 * u.pn + bj;
                    const bool is_rope = (wc == 0) && (hh < 10 || (hh >= 12 && hh < 28));
                    f32x4 v0 = acc[ai][bj][m][0], v1 = acc[ai][bj][m][1];
                    if (is_rope) {
                        f32x4 o0, o1;
#pragma unroll
                        for (int j = 0; j < 4; ++j) { o0[j] = __shfl_xor(v0[j], 32); o1[j] = __shfl_xor(v1[j], 32); }
                        v0 = v0 * c0 + (o0 * s0) * sgn; v1 = v1 * c1 + (o1 * s1) * sgn;
                    }
                    u32x4 w; w.x = pk2(v0[0], v0[1]); w.y = pk2(v0[2], v0[3]); w.z = pk2(v1[0], v1[1]); w.w = pk2(v1[2], v1[3]);
                    *(u32x4*)(O + (size_t)row * DIN + col0 + bj * 128) = w;
                }
            }
    }
};
struct Epi2 {
    static constexpr bool PERM = false;
    const float* x; float* V; const float* ssq;
    __device__ __forceinline__ void scales(int row, float& ra, float& rb) const {
        const f32x4* sp = (const f32x4*)(ssq + (size_t)row * 16);
        const f32x4 a0 = sp[0], a1 = sp[1], b0 = sp[2], b1 = sp[3];
        const float sa = (a0[0] + a0[1]) + (a0[2] + a0[3]) + (a1[0] + a1[1]) + (a1[2] + a1[3]);
        const float sb = (b0[0] + b0[1]) + (b0[2] + b0[3]) + (b1[0] + b1[1]) + (b1[2] + b1[3]);
        ra = 1.0f / sqrtf(sa * (1.0f / 1024.0f) + RMS_EPS); rb = 1.0f / sqrtf(sb * (1.0f / 1024.0f) + RMS_EPS);
    }
    __device__ __forceinline__ void mid(f32x4 (&acc)[2][2][4][2], const g8::Unit& u, int wr, int wc, int fr, int fq) const {
#pragma unroll
        for (int ai = 0; ai < 2; ++ai)
#pragma unroll
            for (int m = 0; m < 4; ++m) { float ra, rb; scales(u.pm * 256 + ai * 128 + wr * 64 + m * 16 + fr, ra, rb); const float f = ra / rb;
#pragma unroll
                for (int bj = 0; bj < 2; ++bj)
#pragma unroll
                    for (int n = 0; n < 2; ++n) acc[ai][bj][m][n] = acc[ai][bj][m][n] * f; }
    }
    __device__ __forceinline__ void operator()(const f32x4 (&acc)[2][2][4][2], const g8::Unit& u, int wr, int wc, int fr, int fq) const {
        const int col0 = u.pn * 256 + wc * 32 + 4 * fq;
#pragma unroll
        for (int ai = 0; ai < 2; ++ai)
#pragma unroll
            for (int m = 0; m < 4; ++m) { const int row = u.pm * 256 + ai * 128 + wr * 64 + m * 16 + fr; float ra, rb; scales(row, ra, rb);
#pragma unroll
                for (int bj = 0; bj < 2; ++bj)
#pragma unroll
                    for (int n = 0; n < 2; ++n) { const size_t off = (size_t)row * DM + col0 + bj * 128 + n * 16;
                        const f32x4 xv = *(const f32x4*)(x + off); *(f32x4*)(V + off) = xv * ALPHA + acc[ai][bj][m][n] * rb; } }
    }
};
struct Epi3 {
    static constexpr bool PERM = true;
    bf16_t* HID; bf16_t* GATE;
    __device__ __forceinline__ void mid(f32x4 (&)[2][2][4][2], const g8::Unit&, int, int, int, int) const {}
    __device__ __forceinline__ void operator()(const f32x4 (&acc)[2][2][4][2], const g8::Unit& u, int wr, int wc, int fr, int fq) const {
        const bool is_gate = u.pn >= DFF / 256;
        bf16_t* base = is_gate ? GATE : HID; const int ldc = is_gate ? DM : KH; const int colt = (is_gate ? u.pn - DFF / 256 : u.pn) * 256;
        const int row0 = u.pm * 256 + wr * 64 + fr, col0 = colt + wc * 32 + 8 * fq;
#pragma unroll
        for (int ai = 0; ai < 2; ++ai)
#pragma unroll
            for (int m = 0; m < 4; ++m)
#pragma unroll
                for (int bj = 0; bj < 2; ++bj) { f32x4 v0 = acc[ai][bj][m][0], v1 = acc[ai][bj][m][1];
                    if (is_gate) {
#pragma unroll
                        for (int j = 0; j < 4; ++j) { v0[j] = 1.0f / (1.0f + __expf(-v0[j])); v1[j] = 1.0f / (1.0f + __expf(-v1[j])); }
                    } else {
#pragma unroll
                        for (int j = 0; j < 4; ++j) { const float a = fmaxf(v0[j], 0.f), b = fmaxf(v1[j], 0.f); v0[j] = a * a; v1[j] = b * b; }
                    }
                    u32x4 w; w.x = pk2(v0[0], v0[1]); w.y = pk2(v0[2], v0[3]); w.z = pk2(v1[0], v1[1]); w.w = pk2(v1[2], v1[3]);
                    *(u32x4*)(base + (size_t)(row0 + ai * 128 + m * 16) * ldc + col0 + bj * 128) = w; }
    }
};
struct Epi4 {
    static constexpr bool PERM = false;
    const bf16_t* GATE; float* H;
    __device__ __forceinline__ void mid(f32x4 (&acc)[2][2][4][2], const g8::Unit& u, int wr, int wc, int fr, int fq) const {
        const int col0 = u.pn * 256 + wc * 32 + 4 * fq;
#pragma unroll
        for (int ai = 0; ai < 2; ++ai)
#pragma unroll
            for (int m = 0; m < 4; ++m) { const int row = u.pm * 256 + ai * 128 + wr * 64 + m * 16 + fr;
#pragma unroll
                for (int bj = 0; bj < 2; ++bj)
#pragma unroll
                    for (int n = 0; n < 2; ++n) { const u32x2 g = *(const u32x2*)(GATE + (size_t)row * DM + col0 + bj * 128 + n * 16);
                        f32x4 gv; gv[0] = bf2f((unsigned short)(g.x & 0xffff)); gv[1] = bf2f((unsigned short)(g.x >> 16)); gv[2] = bf2f((unsigned short)(g.y & 0xffff)); gv[3] = bf2f((unsigned short)(g.y >> 16));
                        acc[ai][bj][m][n] = acc[ai][bj][m][n] * gv; } }
    }
    __device__ __forceinline__ void operator()(const f32x4 (&acc)[2][2][4][2], const g8::Unit& u, int wr, int wc, int fr, int fq) const {
        const int col0 = u.pn * 256 + wc * 32 + 4 * fq;
#pragma unroll
        for (int ai = 0; ai < 2; ++ai)
#pragma unroll
            for (int m = 0; m < 4; ++m) { const int row = u.pm * 256 + ai * 128 + wr * 64 + m * 16 + fr;
#pragma unroll
                for (int bj = 0; bj < 2; ++bj)
#pragma unroll
                    for (int n = 0; n < 2; ++n) { const size_t off = (size_t)row * DM + col0 + bj * 128 + n * 16;
                        const f32x4 hv = *(const f32x4*)(H + off); *(f32x4*)(H + off) = hv * ALPHA + acc[ai][bj][m][n]; } }
    }
};

__device__ __forceinline__ void ln_rows(float* V, bf16_t* OB, const float* g, const float* b, int vb, int nvb) {
    const int tid = threadIdx.x, lane = tid & 63, wave = tid >> 6;
    for (int row = vb * 8 + wave; row < M; row += nvb * 8) {
        f32x4* vr = (f32x4*)(V + (size_t)row * DM) + lane;
        f32x4 v[8]; float s = 0.f;
#pragma unroll
        for (int j = 0; j < 8; ++j) { v[j] = vr[64 * j]; s += (v[j][0] + v[j][1]) + (v[j][2] + v[j][3]); }
        const float mean = wave_sum(s) * (1.0f / DM); float s2 = 0.f;
#pragma unroll
        for (int j = 0; j < 8; ++j) { v[j] = v[j] - mean; s2 += (v[j][0] * v[j][0] + v[j][1] * v[j][1]) + (v[j][2] * v[j][2] + v[j][3] * v[j][3]); }
        const float rstd = 1.0f / sqrtf(wave_sum(s2) * (1.0f / DM) + LN_EPS);
#pragma unroll
        for (int j = 0; j < 8; ++j) { const f32x4 gg = ((const f32x4*)g)[lane + 64 * j], bb = ((const f32x4*)b)[lane + 64 * j];
            const f32x4 o = v[j] * rstd * gg + bb; vr[64 * j] = o;
            if (OB) { u32x2 w; w.x = pk2(o[0], o[1]); w.y = pk2(o[2], o[3]); *((u32x2*)(OB + (size_t)row * DM) + lane + 64 * j) = w; } }
    }
}

__device__ __forceinline__ float dot128(const bf16x8 (&q)[16], const bf16_t* kp) {
    float d = 0.f;
#pragma unroll
    for (int i = 0; i < 16; ++i) { const bf16x8 kv = *(const bf16x8*)(kp + 8 * i);
#pragma unroll
        for (int j = 0; j < 8; ++j) d += bf2f((unsigned short)q[i][j]) * bf2f((unsigned short)kv[j]); }
    return d;
}
__device__ __forceinline__ void attn_naive(const bf16_t* proj, const float* sink, bf16_t* ocat, float* ssq, int vb, int nvb) {
    const int tid = threadIdx.x, lane = tid & 63, wave = tid >> 6;
    for (int item = vb * 8 + wave; item < M * 16; item += nvb * 8) {
        const int m = item >> 4, hs = item & 15, b = m / SEQ, s = m % SEQ;
        const bool isA = hs < 8; const int h = hs & 7;
        const int qc = isA ? C_QA + h * HD : C_QB + h * HD, kc = isA ? C_KA + (h >> 2) * HD : C_KB + h * HD, vc = isA ? C_VA + (h >> 2) * HD : C_VB + h * HD;
        bf16x8 q[16];
#pragma unroll
        for (int i = 0; i < 16; ++i) q[i] = *(const bf16x8*)(proj + (size_t)m * DIN + qc + 8 * i);
        const bf16_t* kb = proj + (size_t)b * SEQ * DIN + kc; const bf16_t* vbp = proj + (size_t)b * SEQ * DIN + vc;
        float sc[9]; int kn[9]; float mx = -1e30f;
        if (isA) {
#pragma unroll
            for (int i = 0; i < 9; ++i) { const int n = s - 128 + lane + 64 * i; const bool ok = (i < 5) && n >= 0 && n < SEQ && n <= s + 128;
                kn[i] = ok ? n : -1; sc[i] = ok ? dot128(q, kb + (size_t)n * DIN) * SM_SCALE : -1e30f; mx = fmaxf(mx, sc[i]); }
        } else {
#pragma unroll
            for (int i = 0; i < 9; ++i) { const int pi = i / 3, r = (pi == 0) ? 1 : (pi == 1) ? 4 : 16; const int j = lane - 64 + 64 * (i % 3); const int n = s + r * j; const bool ok = j <= 64 && n >= 0 && n < SEQ;
                kn[i] = ok ? n : -1; sc[i] = ok ? dot128(q, kb + (size_t)n * DIN) * SM_SCALE : -1e30f; mx = fmaxf(mx, sc[i]); }
        }
        mx = wave_max(mx); const float sk = isA ? sink[h] : -1e30f; mx = fmaxf(mx, sk);
        float den = 0.f; float pr[9];
#pragma unroll
        for (int i = 0; i < 9; ++i) { pr[i] = kn[i] >= 0 ? __expf(sc[i] - mx) : 0.f; den += pr[i]; }
        den = wave_sum(den) + (isA ? __expf(sk - mx) : 0.f);
        float o0 = 0.f, o1 = 0.f;
#pragma unroll
        for (int i = 0; i < 9; ++i) {
            if (isA && i >= 5) continue;
            for (int l = 0; l < 64; ++l) { const float pv = __shfl(pr[i], l); const int n = __shfl(kn[i], l);
                if (n >= 0) { const unsigned vv = *(const unsigned*)(vbp + (size_t)n * DIN + 2 * lane); o0 += pv * bf2f((unsigned short)(vv & 0xffff)); o1 += pv * bf2f((unsigned short)(vv >> 16)); } }
        }
        const float inv = 1.0f / den; o0 *= inv; o1 *= inv;
        *(unsigned*)(ocat + (size_t)m * DM + hs * HD + 2 * lane) = pk2(o0, o1);
        const float q2 = wave_sum(o0 * o0 + o1 * o1);
        if (lane == 0) ssq[(size_t)m * 16 + hs] = q2;
    }
}

struct Args { const float* in[16]; float* out; unsigned char* ws; };
__device__ __forceinline__ PrepArgs mk_prep(const Args& a) { PrepArgs p; p.x = a.in[0]; p.p = a.in[1]; p.pos = (const int*)a.in[2]; p.w_in = a.in[3]; p.gn_a = a.in[5]; p.gn_b = a.in[6]; p.w_o = a.in[7];
    p.w1 = a.in[10]; p.w2 = a.in[11]; p.w_ple = a.in[12]; p.w_gate = a.in[13]; p.ws = a.ws; return p; }
extern __shared__ __attribute__((aligned(16))) unsigned char dyn_lds[];
__global__ void __launch_bounds__(512) k_mega(Args a) {
    cg::grid_group grid = cg::this_grid();
    LAS unsigned char* lds = (LAS unsigned char*)dyn_lds;
    const int vb = blockIdx.x, nvb = gridDim.x;
    { const PrepArgs p = mk_prep(a); prep_phase(p, lds, vb, nvb); }
    grid.sync();
    { const g8::Gemm g{(const bf16_t*)(a.ws + WS_XB), (const bf16_t*)(a.ws + WS_WINT), DM, DM, 0, 0, DM / 64, 0};
      g8::StepOrder<1> S; S.init(M, DIN, nvb, vb);
      Epi1 E{(bf16_t*)(a.ws + WS_PROJ), (const float*)(a.ws + WS_ROPE)};
      g8::gemm_phase<Epi1, 1, true>(lds, g, S, E); }
    grid.sync();
    attn_naive((const bf16_t*)(a.ws + WS_PROJ), a.in[4], (bf16_t*)(a.ws + WS_OCAT), (float*)(a.ws + WS_SSQ), vb, nvb);
    grid.sync();
    { const g8::Gemm g{(const bf16_t*)(a.ws + WS_OCAT), (const bf16_t*)(a.ws + WS_WOT), DM, DM, 0, 1024, 16, 16};
      g8::StepOrder<2> S; S.init(M, DM, nvb, vb);
      Epi2 E{a.in[0], a.out, (const float*)(a.ws + WS_SSQ)};
      g8::gemm_phase<Epi2, 2, true>(lds, g, S, E); }
    grid.sync();
    ln_rows(a.out, (bf16_t*)(a.ws + WS_H1B), a.in[8], a.in[9], vb, nvb);
    p_to_hidp(a.in[1], (bf16_t*)(a.ws + WS_HID), vb, nvb);
    grid.sync();
    { const g8::Gemm g{(const bf16_t*)(a.ws + WS_H1B), (const bf16_t*)(a.ws + WS_W13T), DM, DM, 0, 0, DM / 64, 0};
      g8::StepOrder<1> S; S.init(M, N13, nvb, vb);
      Epi3 E{(bf16_t*)(a.ws + WS_HID), (bf16_t*)(a.ws + WS_GATE)};
      g8::gemm_phase<Epi3, 1, true>(lds, g, S, E); }
    grid.sync();
    { const g8::Gemm g{(const bf16_t*)(a.ws + WS_HID), (const bf16_t*)(a.ws + WS_W2T), KH, KH, DFF, 0, PLE / 64, DFF / 64};
      g8::StepOrder<2> S; S.init(M, DM, nvb, vb);
      Epi4 E{(const bf16_t*)(a.ws + WS_GATE), a.out};
      g8::gemm_phase<Epi4, 2, true>(lds, g, S, E); }
    grid.sync();
    ln_rows(a.out, nullptr, a.in[14], a.in[15], vb, nvb);
}

extern "C" void kernel_launch(void* const* d_in, const int* in_sizes, int n_in, void* d_out, int out_size, void* d_ws, size_t ws_size, hipStream_t stream) {
    if (n_in != 16 || out_size != M * DM || ws_size < WS_END) { fprintf(stderr, "kernel_launch: unexpected shapes (n_in %d out %d ws %zu)\n", n_in, out_size, ws_size); return; }
    constexpr int LDS = 131072;
    static int grid_blocks = 0;
    if (!grid_blocks) {
        int dev = 0, cus = 0, per_cu = 0;
        (void)hipGetDevice(&dev);
        (void)hipDeviceGetAttribute(&cus, hipDeviceAttributeMultiprocessorCount, dev);
        (void)hipFuncSetAttribute((const void*)k_mega, hipFuncAttributeMaxDynamicSharedMemorySize, LDS);
        (void)hipOccupancyMaxActiveBlocksPerMultiprocessor(&per_cu, (const void*)k_mega, 512, LDS);
        if (per_cu < 1) { fprintf(stderr, "kernel_launch: occupancy query says %d blocks/CU\n", per_cu); per_cu = 1; }
        grid_blocks = cus * 1;
        fprintf(stderr, "kernel_launch: cus %d per_cu %d grid %d\n", cus, per_cu, grid_blocks);
    }
    Args a{};
    for (int i = 0; i < 16; ++i) a.in[i] = (const float*)d_in[i];
    a.out = (float*)d_out; a.ws = (unsigned char*)d_ws;
    void* args[] = {&a};
    hipError_t e = hipLaunchCooperativeKernel((const void*)k_mega, dim3(grid_blocks), dim3(512), args, LDS, stream);
    if (e != hipSuccess) fprintf(stderr, "cooperative launch failed: %s (grid %d)\n", hipGetErrorString(e), grid_blocks);
}
```

```cpp
#include <hip/hip_runtime.h>
#include <hip/hip_cooperative_groups.h>
namespace cg = cooperative_groups;
#include <cstdio>
#include <cstdint>

#define LAS __attribute__((address_space(3)))
typedef unsigned short bf16_t;
typedef short bf16x8 __attribute__((ext_vector_type(8)));
typedef float f32x4 __attribute__((ext_vector_type(4)));
typedef float f32x2 __attribute__((ext_vector_type(2)));
typedef unsigned u32x4 __attribute__((ext_vector_type(4)));
typedef unsigned u32x2 __attribute__((ext_vector_type(2)));

constexpr int NB = 8, SEQ = 2048, M = NB * SEQ;
constexpr int DM = 2048, DIN = 4608, DFF = 8192, PLE = 256, HD = 128;
constexpr int N13 = DFF + DM;
constexpr int C_QA = 0, C_KA = 1024, C_VA = 1280, C_QB = 1536, C_KB = 2560, C_VB = 3584;
constexpr float ALPHA = 1.18920711500272f;
constexpr float LN_EPS = 1e-5f, RMS_EPS = 1e-6f;
constexpr float SM_SCALE = 0.08838834764831845f;

constexpr size_t MiB = 1u << 20;
constexpr size_t WS_CTL = 0, WS_ROPE = 1 * MiB, WS_SSQ = 3 * MiB;
constexpr size_t WS_WINT = 6 * MiB, WS_WOT = 24 * MiB, WS_W13T = 32 * MiB, WS_W2T = 72 * MiB  ;
constexpr size_t WS_H1B = 113 * MiB, WS_XB = 113 * MiB  , WS_GATE = 177 * MiB;
constexpr size_t WS_PROJ = 241 * MiB, WS_OCAT = 385 * MiB, WS_HID = 241 * MiB  , WS_END = 505 * MiB;
constexpr int KH = DFF + PLE;

__device__ __forceinline__ unsigned f2bf(float f) { unsigned u = __builtin_bit_cast(unsigned, f); return (u + 0x7fffu + ((u >> 16) & 1u)) >> 16; }
typedef __bf16 bf16x2_t __attribute__((ext_vector_type(2)));
__device__ __forceinline__ unsigned pk2(float lo, float hi) { const f32x2 v = {lo, hi}; return __builtin_bit_cast(unsigned, __builtin_convertvector(v, bf16x2_t)); }
__device__ __forceinline__ float bf2f(unsigned short b) { return __builtin_bit_cast(float, (unsigned)b << 16); }
__device__ __forceinline__ float wave_sum(float v) {
#pragma unroll
    for (int o = 1; o < 64; o <<= 1) v += __shfl_xor(v, o);
    return v;
}
__device__ __forceinline__ float wave_max(float v) {
#pragma unroll
    for (int o = 1; o < 64; o <<= 1) v = fmaxf(v, __shfl_xor(v, o));
    return v;
}

__device__ __forceinline__ void transpose_item(const float* W, int N, bf16_t* WT, int ldk, int koff, int row_off, const float* g, LAS float* scr, int item, int lane) {
    const int nblk = N / 32, kb = item / nblk, nb = item % nblk, k0 = 64 * kb, n0 = 32 * nb;
#pragma unroll 8
    for (int i = 0; i < 32; ++i) { const int kk = 2 * i + (lane >> 5); float v = W[(size_t)(k0 + kk) * N + n0 + (lane & 31)]; if (g) v *= g[k0 + kk]; scr[kk * 33 + (lane & 31)] = v; }
    asm volatile("s_waitcnt lgkmcnt(0)" ::: "memory");
    const int c = lane & 7;
#pragma unroll
    for (int j = 0; j < 4; ++j) { const int n = (lane >> 3) + 8 * j; const LAS float* s = scr + (8 * c) * 33 + n;
        u32x4 o; o.x = pk2(s[0 * 33], s[1 * 33]); o.y = pk2(s[2 * 33], s[3 * 33]); o.z = pk2(s[4 * 33], s[5 * 33]); o.w = pk2(s[6 * 33], s[7 * 33]);
        *(u32x4*)(WT + (size_t)(row_off + n0 + n) * ldk + koff + k0 + 8 * c) = o; }
    asm volatile("s_waitcnt lgkmcnt(0)" ::: "memory");
}
__device__ __forceinline__ void sincos_d(double x, float& s, float& c) {
    const double k = __builtin_rint(x * 0.63661977236758134308);
    double r = __builtin_fma(-k, 1.57079632679489655800e+00, x); r = __builtin_fma(-k, 6.12323399573676603587e-17, r);
    const double r2 = r * r;
    double sp = -1.0 / 1307674368000.0; sp = sp * r2 + 1.0 / 6227020800.0; sp = sp * r2 - 1.0 / 39916800.0; sp = sp * r2 + 1.0 / 362880.0; sp = sp * r2 - 1.0 / 5040.0; sp = sp * r2 + 1.0 / 120.0; sp = sp * r2 - 1.0 / 6.0; sp = sp * r2 + 1.0;
    const double sn = sp * r;
    double cp = 1.0 / 20922789888000.0; cp = cp * r2 - 1.0 / 87178291200.0; cp = cp * r2 + 1.0 / 479001600.0; cp = cp * r2 - 1.0 / 3628800.0; cp = cp * r2 + 1.0 / 40320.0; cp = cp * r2 - 1.0 / 720.0; cp = cp * r2 + 1.0 / 24.0; cp = cp * r2 - 0.5; cp = cp * r2 + 1.0;
    const int q = ((int)k) & 3;
    const double ss = (q == 0) ? sn : (q == 1) ? cp : (q == 2) ? -sn : -cp;
    const double cc = (q == 0) ? cp : (q == 1) ? -sn : (q == 2) ? -cp : sn;
    s = (float)ss; c = (float)cc;
}
struct PrepArgs { const float *x, *p, *w_in, *gn_a, *gn_b, *w_o, *w1, *w2, *w_ple, *w_gate; const int* pos; unsigned char* ws; };
__device__ __forceinline__ void prep_phase(const PrepArgs& a, LAS unsigned char* lds, int vb, int nvb) {
    const int tid = threadIdx.x, lane = tid & 63, wave = tid >> 6;
    LAS float* scr = (LAS float*)(lds + wave * 16384);
    const int gw = vb * 8 + wave, ngw = nvb * 8;
    bf16_t* WinT = (bf16_t*)(a.ws + WS_WINT); bf16_t* WoT = (bf16_t*)(a.ws + WS_WOT); bf16_t* W13T = (bf16_t*)(a.ws + WS_W13T); bf16_t* W2T = (bf16_t*)(a.ws + WS_W2T);
    constexpr int I_IN = (DM / 64) * (DIN / 32), I_O = (DM / 64) * (DM / 32), I_1 = (DM / 64) * (DFF / 32), I_G = I_O, I_2 = (DFF / 64) * (DM / 32), I_P = (PLE / 64) * (DM / 32);
    constexpr int NITEMS = I_IN + I_O + I_1 + I_G + I_2 + I_P;
    for (int it = gw; it < NITEMS; it += ngw) {
        int r = it;
        if (r < I_IN) { transpose_item(a.w_in, DIN, WinT, DM, 0, 0, nullptr, scr, r, lane); continue; } r -= I_IN;
        if (r < I_O) { const int kb = r / (DM / 32);
            transpose_item(a.w_o, DM, WoT, DM, 0, 0, (kb < 16) ? a.gn_a : (a.gn_b - 1024), scr, r, lane); continue; } r -= I_O;
        if (r < I_1) { transpose_item(a.w1, DFF, W13T, DM, 0, 0, nullptr, scr, r, lane); continue; } r -= I_1;
        if (r < I_G) { transpose_item(a.w_gate, DM, W13T, DM, 0, DFF, nullptr, scr, r, lane); continue; } r -= I_G;
        if (r < I_2) { transpose_item(a.w2, DM, W2T, KH, 0, 0, nullptr, scr, r, lane); continue; } r -= I_2;
        transpose_item(a.w_ple, DM, W2T, KH, DFF, 0, nullptr, scr, r, lane);
    }
    bf16_t* XB = (bf16_t*)(a.ws + WS_XB);
    const size_t gt = (size_t)vb * 512 + tid, ngt = (size_t)nvb * 512;
    for (size_t i = gt; i < (size_t)M * DM / 8; i += ngt) { const f32x4 v0 = ((const f32x4*)a.x)[2 * i], v1 = ((const f32x4*)a.x)[2 * i + 1];
        u32x4 o; o.x = pk2(v0.x, v0.y); o.y = pk2(v0.z, v0.w); o.z = pk2(v1.x, v1.y); o.w = pk2(v1.z, v1.w); ((u32x4*)XB)[i] = o; }
    float* rope = (float*)(a.ws + WS_ROPE);
    for (size_t i = gt; i < (size_t)M * 16; i += ngt) { const int m = (int)(i >> 4), j = (int)(i & 15);
        const double invf = ::exp2(-(double)j * (1.0 / 16.0) * 18.931568569324174);
        float s, c; sincos_d((double)a.pos[m] * invf, s, c); rope[(size_t)m * 32 + j] = c; rope[(size_t)m * 32 + 16 + j] = s; }
}
__device__ __forceinline__ void p_to_hidp(const float* p, bf16_t* HIDP, int vb, int nvb) {
    const size_t gt = (size_t)vb * 512 + threadIdx.x, ngt = (size_t)nvb * 512;
    for (size_t i = gt; i < (size_t)M * PLE / 8; i += ngt) { const f32x4 v0 = ((const f32x4*)p)[2 * i], v1 = ((const f32x4*)p)[2 * i + 1];
        const size_t row = i / (PLE / 8), c8 = i % (PLE / 8);
        u32x4 o; o.x = pk2(v0.x, v0.y); o.y = pk2(v0.z, v0.w); o.z = pk2(v1.x, v1.y); o.w = pk2(v1.z, v1.w); *(u32x4*)(HIDP + row * KH + DFF + c8 * 8) = o; }
}
namespace g8 {
constexpr int BM = 256, BK = 64, HALF = 128, HTB = HALF * BK * 2  , STAGE_BYTES = 8 * HTB, NXCD = 8, WGM = 8;
__host__ __device__ __forceinline__ int lds_byte(int r, int c) { const int st = (r >> 4) * 2 + (c >> 5), rr = r & 15, cc = c & 31, ob = rr * 64 + cc * 2; return st * 1024 + (ob ^ (((ob >> 9) & 1) << 5)); }
__host__ __device__ __forceinline__ void stage_rc(int b, int& R, int& C) { const int st = b / 1024, sb = b % 1024, swz = sb ^ (((sb >> 9) & 1) << 5); R = (st >> 1) * 16 + swz / 64; C = (st & 1) * 32 + (swz % 64) / 2; }
__host__ __device__ __forceinline__ int perm32(int rho) { const int n = rho >> 4, i = rho & 15; return 8 * (i >> 2) + 4 * n + (i & 3); }
struct Unit { int pm, pn, seg; };
struct Gemm { const bf16_t* A; const bf16_t* Bt; int lda, ldb; int kofs0, kofs1; int nt0, nt1; };
template <int NSEG> struct StepOrder {
    int nM, nN, nwg, G, c;
    __device__ void init(int M_, int N_, int G_, int c_) { nM = M_ / BM; nN = N_ / BM; nwg = nM * nN; G = G_; c = c_; }
    __device__ __forceinline__ bool next(int i, Unit& u) const {
        const int ui = (NSEG == 2) ? (i >> 1) : i; u.seg = (NSEG == 2) ? (i & 1) : 0;
        const long L = (long)ui * G + c; if (L >= nwg) return false;
        int wgid = (int)L; { const int q = nwg / NXCD, r = nwg % NXCD, xcd = wgid % NXCD, off = wgid / NXCD; wgid = (xcd < r ? xcd * (q + 1) : r * (q + 1) + (xcd - r) * q) + off; }
        const int nig = WGM * nN, gid = wgid / nig, fm = gid * WGM, gsz = (nM - fm) < WGM ? (nM - fm) : WGM;
        u.pm = fm + ((wgid % nig) % gsz); u.pn = (wgid % nig) / gsz; return true;
    }
};
template <class Epi, int NSEG, bool ALIGN_EPI>
__device__ __forceinline__ void gemm_phase(LAS unsigned char* lds, const Gemm g, const StepOrder<NSEG>& S, const Epi& E) {
    int tid_ = threadIdx.x; asm volatile("" : "+v"(tid_));
    const int tid = tid_, wid = __builtin_amdgcn_readfirstlane(tid >> 6), lane = tid & 63, wr = wid >> 2, wc = wid & 3, fr = lane & 15, fq = lane >> 4;
    unsigned voffA[2], voffB[2];
#pragma unroll
    for (int i = 0; i < 2; ++i) { int R, C; stage_rc(tid * 16 + i * 8192, R, C); const int Rb = Epi::PERM ? ((R & ~31) + perm32(R & 31)) : R;
        voffA[i] = (unsigned)(R * g.lda + C) * 2u; voffB[i] = (unsigned)(Rb * g.ldb + C) * 2u; }
    const size_t kstep = (size_t)(BK * 2);
    const size_t hstepA = (size_t)HALF * g.lda * 2, hstepB = (size_t)HALF * g.ldb * 2, tstepA = 2 * hstepA, tstepB = 2 * hstepB;
    const unsigned ldsw = (unsigned)wid * 1024u;
    const int aoff = lds_byte(wr * 64 + fr, fq * 8), boff = lds_byte(wc * 32 + fr, fq * 8);
#define PG8_SA(b, h) (((b) * 2 + (h)) * g8::HTB)
#define PG8_SB(b, h) ((4 + (b) * 2 + (h)) * g8::HTB)
#define PG8_STAGE(bufoff, gbase, voff) do { _Pragma("unroll") for (int _i = 0; _i < 2; ++_i) \
        __builtin_amdgcn_global_load_lds((const unsigned*)((const char*)(gbase) + (voff)[_i]), (LAS unsigned*)(lds + (bufoff) + ldsw + _i * 8192), 16, 0, 0); } while (0)
#define PG8_LDA(dst, b, h) do { _Pragma("unroll") for (int m = 0; m < 4; ++m) _Pragma("unroll") for (int k = 0; k < 2; ++k) dst[m][k] = *(const LAS bf16x8*)(lds + PG8_SA(b, h) + aoff + m * 2048 + k * 1024); } while (0)
#define PG8_LDB(dst, b, h) do { _Pragma("unroll") for (int n = 0; n < 2; ++n) _Pragma("unroll") for (int k = 0; k < 2; ++k) dst[n][k] = *(const LAS bf16x8*)(lds + PG8_SB(b, h) + boff + n * 2048 + k * 1024); } while (0)
#define PG8_MMA(ai, bj, At, Bt) do { __builtin_amdgcn_s_setprio(1); _Pragma("unroll") for (int m = 0; m < 4; ++m) _Pragma("unroll") for (int n = 0; n < 2; ++n) _Pragma("unroll") for (int k = 0; k < 2; ++k) \
        acc[ai][bj][m][n] = __builtin_amdgcn_mfma_f32_16x16x32_bf16(Bt[n][k], At[m][k], acc[ai][bj][m][n], 0, 0, 0); __builtin_amdgcn_s_setprio(0); } while (0)
#define PG8_WAIT_V(n) asm volatile("s_waitcnt vmcnt(" #n ")" ::: "memory")
#define PG8_WAIT_L(n) asm volatile("s_waitcnt lgkmcnt(" #n ")" ::: "memory")
#define PG8_BAR __builtin_amdgcn_s_barrier()
#define PG8_SCHED __builtin_amdgcn_sched_barrier(0)
#define PG8_BASEA(u) ((const char*)g.A + (size_t)(u).pm * tstepA + (size_t)((u).seg ? g.kofs1 : g.kofs0) * 2)
#define PG8_BASEB(u) ((const char*)g.Bt + (size_t)(u).pn * tstepB + (size_t)((u).seg ? g.kofs1 : g.kofs0) * 2)
    Unit cur, nxt; int ui = 0;
    if (!S.next(0, cur)) return;
    f32x4 acc[2][2][4][2];
#pragma unroll
    for (int a = 0; a < 2; ++a)
#pragma unroll
        for (int b = 0; b < 2; ++b)
#pragma unroll
            for (int m = 0; m < 4; ++m)
#pragma unroll
                for (int n = 0; n < 2; ++n) acc[a][b][m][n] = (f32x4){0.f, 0.f, 0.f, 0.f};
    bf16x8 At[4][2], B0[2][2], B1[2][2];
    const char* cA = PG8_BASEA(cur); const char* cB = PG8_BASEB(cur);
    PG8_STAGE(PG8_SB(0, 0), cB, voffB); PG8_STAGE(PG8_SB(0, 1), cB + hstepB, voffB); PG8_STAGE(PG8_SA(0, 0), cA, voffA); PG8_STAGE(PG8_SA(0, 1), cA + hstepA, voffA);
    if (wr == 1) PG8_BAR;
    PG8_WAIT_V(2); PG8_BAR;
    PG8_STAGE(PG8_SB(1, 0), cB + kstep, voffB); PG8_STAGE(PG8_SA(1, 0), cA + kstep, voffA); PG8_STAGE(PG8_SB(1, 1), cB + hstepB + kstep, voffB);
    PG8_WAIT_V(6); PG8_BAR;
    for (;;) {
        const bool has_next = S.next(ui + 1, nxt);
        const char* nA = has_next ? PG8_BASEA(nxt) : cA; const char* nB = has_next ? PG8_BASEB(nxt) : cB;
        const int nt = cur.seg ? g.nt1 : g.nt0;
        for (int t = 0; t < nt; t += 2) {
            const bool last = (t == nt - 2);
            const char* a1 = cA + (size_t)(t + 1) * kstep;
            const char* a2 = last ? nA : cA + (size_t)(t + 2) * kstep; const char* b2 = last ? nB : cB + (size_t)(t + 2) * kstep;
            const char* a3 = a2 + kstep; const char* b3 = b2 + kstep;
            PG8_LDB(B0, 0, 0); PG8_LDB(B1, 0, 1); PG8_SCHED; PG8_LDA(At, 0, 0); PG8_STAGE(PG8_SA(1, 1), a1 + hstepA, voffA);
            PG8_WAIT_V(8); PG8_WAIT_L(0); PG8_BAR; PG8_MMA(0, 0, At, B0); PG8_MMA(0, 1, At, B1); PG8_BAR; PG8_SCHED;
            PG8_LDA(At, 0, 1); PG8_STAGE(PG8_SB(0, 0), b2, voffB); PG8_STAGE(PG8_SB(0, 1), b2 + hstepB, voffB); PG8_STAGE(PG8_SA(0, 0), a2, voffA);
            PG8_WAIT_V(8); PG8_WAIT_L(0); PG8_BAR; PG8_MMA(1, 0, At, B0); PG8_MMA(1, 1, At, B1); PG8_BAR; PG8_SCHED;
            PG8_LDB(B0, 1, 0); PG8_LDB(B1, 1, 1); PG8_SCHED; PG8_LDA(At, 1, 0); PG8_STAGE(PG8_SA(0, 1), a2 + hstepA, voffA);
            PG8_WAIT_V(8); PG8_WAIT_L(0); PG8_BAR; PG8_MMA(0, 0, At, B0); PG8_MMA(0, 1, At, B1); PG8_BAR; PG8_SCHED;
            PG8_LDA(At, 1, 1); PG8_STAGE(PG8_SB(1, 0), b3, voffB); PG8_STAGE(PG8_SB(1, 1), b3 + hstepB, voffB); PG8_STAGE(PG8_SA(1, 0), a3, voffA);
            PG8_WAIT_V(8); PG8_WAIT_L(0); PG8_BAR; PG8_MMA(1, 0, At, B0); PG8_MMA(1, 1, At, B1); PG8_BAR; PG8_SCHED;
        }
        if constexpr (ALIGN_EPI) { if (wr == 0) PG8_BAR; }
        const bool fin = (NSEG == 1) || (cur.seg == NSEG - 1);
        if (fin) E(acc, cur, wr, wc, fr, fq); else E.mid(acc, cur, wr, wc, fr, fq);
        if (!has_next) break;
        if (fin) {
#pragma unroll
            for (int a = 0; a < 2; ++a)
#pragma unroll
                for (int b = 0; b < 2; ++b)
#pragma unroll
                    for (int m = 0; m < 4; ++m)
#pragma unroll
                        for (int n = 0; n < 2; ++n) acc[a][b][m][n] = (f32x4){0.f, 0.f, 0.f, 0.f};
        }
        cur = nxt; cA = nA; cB = nB; ++ui;
        if constexpr (ALIGN_EPI) { if (wr == 1) PG8_BAR; }
    }
    PG8_WAIT_V(0);
    if constexpr (!ALIGN_EPI) { if (wr == 0) PG8_BAR; }
    PG8_BAR;
#undef PG8_SA
#undef PG8_SB
#undef PG8_STAGE
#undef PG8_LDA
#undef PG8_LDB
#undef PG8_MMA
#undef PG8_WAIT_V
#undef PG8_WAIT_L
#undef PG8_BAR
#undef PG8_SCHED
#undef PG8_BASEA
#undef PG8_BASEB
}
}

struct Epi1 {
    static constexpr bool PERM = true;
    bf16_t* O; const float* rope;
    __device__ __forceinline__ void mid(f32x4 (&)[2][2][4][2], const g8::Unit&, int, int, int, int) const {}
    __device__ __forceinline__ void operator()(const f32x4 (&acc)[2][2][4][2], const g8::Unit& u, int wr, int wc, int fr, int fq) const {
        const int row0 = u.pm * 256 + wr * 64 + fr, col0 = u.pn * 256 + wc * 32 + 8 * fq;
        const float sgn = fq < 2 ? -1.f : 1.f;
#pragma unroll
        for (int ai = 0; ai < 2; ++ai)
#pragma unroll
            for (int m = 0; m < 4; ++m) {
                const int row = row0 + ai * 128 + m * 16;
                const float* rp = rope + (size_t)row * 32 + 8 * (fq & 1);
                const f32x4 c0 = *(const f32x4*)(rp), c1 = *(const f32x4*)(rp + 4), s0 = *(const f32x4*)(rp + 16), s1 = *(const f32x4*)(rp + 20);
#pragma unroll
                for (int bj = 0; bj < 2; ++bj) {
                    const int hh = 2 * u.pn + bj;
                    const bool is_rope = (wc == 0) && (hh < 10 || (hh >= 12 && hh < 28));
                    f32x4 v0 = acc[ai][bj][m][0], v1 = acc[ai][bj][m][1];
                    if (is_rope) {
                        f32x4 o0, o1;
#pragma unroll
                        for (int j = 0; j < 4; ++j) { o0[j] = __shfl_xor(v0[j], 32); o1[j] = __shfl_xor(v1[j], 32); }
                        v0 = v0 * c0 + (o0 * s0) * sgn; v1 = v1 * c1 + (o1 * s1) * sgn;
                    }
                    u32x4 w; w.x = pk2(v0[0], v0[1]); w.y = pk2(v0[2], v0[3]); w.z = pk2(v1[0], v1[1]); w.w = pk2(v1[2], v1[3]);
                    *(u32x4*)(O + (size_t)row * DIN + col0 + bj * 128) = w;
                }
            }
    }
};
struct Epi2 {
    static constexpr bool PERM = false;
    const float* x; float* V; const float* ssq;
    __device__ __forceinline__ void scales(int row, float& ra, float& rb) const {
        const f32x4* sp = (const f32x4*)(ssq + (size_t)row * 16);
        const f32x4 a0 = sp[0], a1 = sp[1], b0 = sp[2], b1 = sp[3];
        const float sa = (a0[0] + a0[1]) + (a0[2] + a0[3]) + (a1[0] + a1[1]) + (a1[2] + a1[3]);
        const float sb = (b0[0] + b0[1]) + (b0[2] + b0[3]) + (b1[0] + b1[1]) + (b1[2] + b1[3]);
        ra = 1.0f / sqrtf(sa * (1.0f / 1024.0f) + RMS_EPS); rb = 1.0f / sqrtf(sb * (1.0f / 1024.0f) + RMS_EPS);
    }
    __device__ __forceinline__ void mid(f32x4 (&acc)[2][2][4][2], const g8::Unit& u, int wr, int wc, int fr, int fq) const {
#pragma unroll
        for (int ai = 0; ai < 2; ++ai)
#pragma unroll
            for (int m = 0; m < 4; ++m) { float ra, rb; scales(u.pm * 256 + ai * 128 + wr * 64 + m * 16 + fr, ra, rb); const float f = ra / rb;
#pragma unroll
                for (int bj = 0; bj < 2; ++bj)
#pragma unroll
                    for (int n = 0; n < 2; ++n) acc[ai][bj][m][n] = acc[ai][bj][m][n] * f; }
    }
    __device__ __forceinline__ void operator()(const f32x4 (&acc)[2][2][4][2], const g8::Unit& u, int wr, int wc, int fr, int fq) const {
        const int col0 = u.pn * 256 + wc * 32 + 4 * fq;
#pragma unroll
        for (int ai = 0; ai < 2; ++ai)
#pragma unroll
            for (int m = 0; m < 4; ++m) { const int row = u.pm * 256 + ai * 128 + wr * 64 + m * 16 + fr; float ra, rb; scales(row, ra, rb);
#pragma unroll
                for (int bj = 0; bj < 2; ++bj)
#pragma unroll
                    for (int n = 0; n < 2; ++n) { const size_t off = (size_t)row * DM + col0 + bj * 128 + n * 16;
                        const f32x4 xv = *(const f32x4*)(x + off); *(f32x4*)(V + off) = xv * ALPHA + acc[ai][bj][m][n] * rb; } }
    }
};
struct Epi3 {
    static constexpr bool PERM = true;
    bf16_t* HID; bf16_t* GATE;
    __device__ __forceinline__ void mid(f32x4 (&)[2][2][4][2], const g8::Unit&, int, int, int, int) const {}
    __device__ __forceinline__ void operator()(const f32x4 (&acc)[2][2][4][2], const g8::Unit& u, int wr, int wc, int fr, int fq) const {
        const bool is_gate = u.pn >= DFF / 256;
        bf16_t* base = is_gate ? GATE : HID; const int ldc = is_gate ? DM : KH; const int colt = (is_gate ? u.pn - DFF / 256 : u.pn) * 256;
        const int row0 = u.pm * 256 + wr * 64 + fr, col0 = colt + wc * 32 + 8 * fq;
#pragma unroll
        for (int ai = 0; ai < 2; ++ai)
#pragma unroll
            for (int m = 0; m < 4; ++m)
#pragma unroll
                for (int bj = 0; bj < 2; ++bj) { f32x4 v0 = acc[ai][bj][m][0], v1 = acc[ai][bj][m][1];
                    if (is_gate) {
#pragma unroll
                        for (int j = 0; j < 4; ++j) { v0[j] = 1.0f / (1.0f + __expf(-v0[j])); v1[j] = 1.0f / (1.0f + __expf(-v1[j])); }
                    } else {
#pragma unroll
                        for (int j = 0; j < 4; ++j) { const float a = fmaxf(v0[j], 0.f), b = fmaxf(v1[j], 0.f); v0[j] = a * a; v1[j] = b * b; }
                    }
                    u32x4 w; w.x = pk2(v0[0], v0[1]); w.y = pk2(v0[2], v0[3]); w.z = pk2(v1[0], v1[1]); w.w = pk2(v1[2], v1[3]);
                    *(u32x4*)(base + (size_t)(row0 + ai * 128 + m * 16) * ldc + col0 + bj * 128) = w; }
    }
};
struct Epi4 {
    static constexpr bool PERM = false;
    const bf16_t* GATE; float* H;
    __device__ __forceinline__ void mid(f32x4 (&acc)[2][2][4][2], const g8::Unit& u, int wr, int wc, int fr, int fq) const {
        const int col0 = u.pn * 256 + wc * 32 + 4 * fq;
#pragma unroll
        for (int ai = 0; ai < 2; ++ai)
#pragma unroll
            for (int m = 0; m < 4; ++m) { const int row = u.pm * 256 + ai * 128 + wr * 64 + m * 16 + fr;
#pragma unroll
                for (int bj = 0; bj < 2; ++bj)
#pragma unroll
                    for (int n = 0; n < 2; ++n) { const u32x2 g = *(const u32x2*)(GATE + (size_t)row * DM + col0 + bj * 128 + n * 16);
                        f32x4 gv; gv[0] = bf2f((unsigned short)(g.x & 0xffff)); gv[1] = bf2f((unsigned short)(g.x >> 16)); gv[2] = bf2f((unsigned short)(g.y & 0xffff)); gv[3] = bf2f((unsigned short)(g.y >> 16));
                        acc[ai][bj][m][n] = acc[ai][bj][m][n] * gv; } }
    }
    __device__ __forceinline__ void operator()(const f32x4 (&acc)[2][2][4][2], const g8::Unit& u, int wr, int wc, int fr, int fq) const {
        const int col0 = u.pn * 256 + wc * 32 + 4 * fq;
#pragma unroll
        for (int ai = 0; ai < 2; ++ai)
#pragma unroll
            for (int m = 0; m < 4; ++m) { const int row = u.pm * 256 + ai * 128 + wr * 64 + m * 16 + fr;
#pragma unroll
                for (int bj = 0; bj < 2; ++bj)
#pragma unroll
                    for (int n = 0; n < 2; ++n) { const size_t off = (size_t)row * DM + col0 + bj * 128 + n * 16;
                        const f32x4 hv = *(const f32x4*)(H + off); *(f32x4*)(H + off) = hv * ALPHA + acc[ai][bj][m][n]; } }
    }
};

__device__ __forceinline__ void ln_rows(float* V, bf16_t* OB, const float* g, const float* b, int vb, int nvb) {
    const int tid = threadIdx.x, lane = tid & 63, wave = tid >> 6;
    for (int row = vb * 8 + wave; row < M; row += nvb * 8) {
        f32x4* vr = (f32x4*)(V + (size_t)row * DM) + lane;
        f32x4 v[8]; float s = 0.f;
#pragma unroll
        for (int j = 0; j < 8; ++j) { v[j] = vr[64 * j]; s += (v[j][0] + v[j][1]) + (v[j][2] + v[j][3]); }
        const float mean = wave_sum(s) * (1.0f / DM); float s2 = 0.f;
#pragma unroll
        for (int j = 0; j < 8; ++j) { v[j] = v[j] - mean; s2 += (v[j][0] * v[j][0] + v[j][1] * v[j][1]) + (v[j][2] * v[j][2] + v[j][3] * v[j][3]); }
        const float rstd = 1.0f / sqrtf(wave_sum(s2) * (1.0f / DM) + LN_EPS);
#pragma unroll
        for (int j = 0; j < 8; ++j) { const f32x4 gg = ((const f32x4*)g)[lane + 64 * j], bb = ((const f32x4*)b)[lane + 64 * j];
            const f32x4 o = v[j] * rstd * gg + bb; vr[64 * j] = o;
            if (OB) { u32x2 w; w.x = pk2(o[0], o[1]); w.y = pk2(o[2], o[3]); *((u32x2*)(OB + (size_t)row * DM) + lane + 64 * j) = w; } }
    }
}

__device__ __forceinline__ float dot128(const bf16x8 (&q)[16], const bf16_t* kp) {
    float d = 0.f;
#pragma unroll
    for (int i = 0; i < 16; ++i) { const bf16x8 kv = *(const bf16x8*)(kp + 8 * i);
#pragma unroll
        for (int j = 0; j < 8; ++j) d += bf2f((unsigned short)q[i][j]) * bf2f((unsigned short)kv[j]); }
    return d;
}
__device__ __forceinline__ void attn_naive(const bf16_t* proj, const float* sink, bf16_t* ocat, float* ssq, int vb, int nvb) {
    const int tid = threadIdx.x, lane = tid & 63, wave = tid >> 6;
    for (int item = vb * 8 + wave; item < M * 16; item += nvb * 8) {
        const int m = item >> 4, hs = item & 15, b = m / SEQ, s = m % SEQ;
        const bool isA = hs < 8; const int h = hs & 7;
        const int qc = isA ? C_QA + h * HD : C_QB + h * HD, kc = isA ? C_KA + (h >> 2) * HD : C_KB + h * HD, vc = isA ? C_VA + (h >> 2) * HD : C_VB + h * HD;
        bf16x8 q[16];
#pragma unroll
        for (int i = 0; i < 16; ++i) q[i] = *(const bf16x8*)(proj + (size_t)m * DIN + qc + 8 * i);
        const bf16_t* kb = proj + (size_t)b * SEQ * DIN + kc; const bf16_t* vbp = proj + (size_t)b * SEQ * DIN + vc;
        float sc[9]; int kn[9]; float mx = -1e30f;
        if (isA) {
#pragma unroll
            for (int i = 0; i < 9; ++i) { const int n = s - 128 + lane + 64 * i; const bool ok = (i < 5) && n >= 0 && n < SEQ && n <= s + 128;
                kn[i] = ok ? n : -1; sc[i] = ok ? dot128(q, kb + (size_t)n * DIN) * SM_SCALE : -1e30f; mx = fmaxf(mx, sc[i]); }
        } else {
#pragma unroll
            for (int i = 0; i < 9; ++i) { const int pi = i / 3, r = (pi == 0) ? 1 : (pi == 1) ? 4 : 16; const int j = lane - 64 + 64 * (i % 3); const int n = s + r * j; const bool ok = j <= 64 && n >= 0 && n < SEQ;
                kn[i] = ok ? n : -1; sc[i] = ok ? dot128(q, kb + (size_t)n * DIN) * SM_SCALE : -1e30f; mx = fmaxf(mx, sc[i]); }
        }
        mx = wave_max(mx); const float sk = isA ? sink[h] : -1e30f; mx = fmaxf(mx, sk);
        float den = 0.f; float pr[9];
#pragma unroll
        for (int i = 0; i < 9; ++i) { pr[i] = kn[i] >= 0 ? __expf(sc[i] - mx) : 0.f; den += pr[i]; }
        den = wave_sum(den) + (isA ? __expf(sk - mx) : 0.f);
        float o0 = 0.f, o1 = 0.f;
#pragma unroll
        for (int i = 0; i < 9; ++i) {
            if (isA && i >= 5) continue;
            for (int l = 0; l < 64; ++l) { const float pv = __shfl(pr[i], l); const int n = __shfl(kn[i], l);
                if (n >= 0) { const unsigned vv = *(const unsigned*)(vbp + (size_t)n * DIN + 2 * lane); o0 += pv * bf2f((unsigned short)(vv & 0xffff)); o1 += pv * bf2f((unsigned short)(vv >> 16)); } }
        }
        const float inv = 1.0f / den; o0 *= inv; o1 *= inv;
        *(unsigned*)(ocat + (size_t)m * DM + hs * HD + 2 * lane) = pk2(o0, o1);
        const float q2 = wave_sum(o0 * o0 + o1 * o1);
        if (lane == 0) ssq[(size_t)m * 16 + hs] = q2;
    }
}

typedef float f32x16 __attribute__((ext_vector_type(16)));
typedef short s16x4 __attribute__((ext_vector_type(4)));
constexpr float SC2 = SM_SCALE * 1.4426950408889634f;
__device__ __forceinline__ int crow(int r, int h) { return (r & 3) + 8 * (r >> 2) + 4 * h; }
__device__ __forceinline__ s16x4 vtr(LAS unsigned char* p) { return __builtin_bit_cast(s16x4, __builtin_amdgcn_ds_read_tr16_b64_v4i16((LAS s16x4*)p)); }

template <bool IS_A> __device__ __forceinline__ void tile_params(int ii, int qbase, int& kb, int& ks, int& hl) {
    if (IS_A) { const int i = (ii == 0) ? 4 : (ii <= 4 ? ii - 1 : ii); kb = qbase - 128 + 32 * i; ks = 1; hl = 128; }
    else { const int i = (ii == 0) ? 2 : (ii <= 2 ? ii - 1 : ii);
        if (i < 5) { kb = qbase - 1024 + 512 * i; ks = 16; hl = 1024; }
        else if (i < 13) { kb = qbase - 256 + 128 * (i - 5); ks = 4; hl = 256; }
        else { kb = qbase - 64 + 32 * (i - 13); ks = 1; hl = 64; } }
}
template <bool IS_A>
__device__ __forceinline__ void attn_item(const bf16_t* pb  , int qcol, int kcol, int vcol, int qbase, float sink2,
                                          bf16_t* ob  , float* sq  , LAS unsigned char* vl, int lane) {
    constexpr int QS = IS_A ? 1 : 16, NT = IS_A ? 9 : 33;
    const int r = lane & 31, h = lane >> 5;
    const int tq = qbase + QS * r;
    LAS unsigned char* ql = vl + 8192;
    { const int qc = lane & 15;
#pragma unroll
      for (int i = 0; i < 8; ++i) { const int row = 4 * i + (lane >> 4); const u32x4 v = *(const u32x4*)(pb + (size_t)(qbase + QS * row) * DIN + qcol + 8 * qc);
          *(LAS u32x4*)(ql + row * 256 + ((qc ^ (row & 15)) * 16)) = v; } }
    const LAS unsigned char* qrd = ql + r * 256;
    f32x16 o[4];
#pragma unroll
    for (int db = 0; db < 4; ++db)
#pragma unroll
        for (int i = 0; i < 16; ++i) o[db][i] = 0.f;
    float m = -1e30f, l = 0.f;
    const int vkey = lane >> 4, vc8 = lane & 15;
    LAS unsigned char* vwr = vl + (vc8 >> 2) * 512 + (vc8 & 3) * 16 + (vkey & 7) * 64;
    LAS unsigned char* vrd = vl + (4 * h + ((lane & 15) >> 2)) * 64 + ((lane >> 4) & 1) * 32 + (lane & 3) * 8;
    bf16x8 kf[8]; u32x4 vr[8];
    int kb, ks, hl; tile_params<IS_A>(0, qbase, kb, ks, hl);
#define ATT_LOADK(kb_, ks_) do { int kt_ = (kb_) + (ks_) * r; kt_ = kt_ < 0 ? 0 : (kt_ > SEQ - 1 ? SEQ - 1 : kt_); const bf16_t* kp_ = pb + (size_t)kt_ * DIN + kcol + 8 * h; \
        _Pragma("unroll") for (int d0 = 0; d0 < 8; ++d0) kf[d0] = *(const bf16x8*)(kp_ + 16 * d0); } while (0)
#define ATT_LOADV(kb_, ks_) do { _Pragma("unroll") for (int i = 0; i < 8; ++i) { int kt_ = (kb_) + (ks_) * (4 * i + vkey); kt_ = kt_ < 0 ? 0 : (kt_ > SEQ - 1 ? SEQ - 1 : kt_); \
        vr[i] = *(const u32x4*)(pb + (size_t)kt_ * DIN + vcol + 8 * vc8); } } while (0)
    ATT_LOADK(kb, ks); ATT_LOADV(kb, ks);
#pragma unroll 1
    for (int ii = 0; ii < NT; ++ii) {
#pragma unroll
        for (int i = 0; i < 8; ++i) *(LAS u32x4*)(vwr + (i >> 1) * 2048 + (i & 1) * 256) = vr[i];
        int kb2, ks2, hl2; tile_params<IS_A>(ii + 1 < NT ? ii + 1 : NT - 1, qbase, kb2, ks2, hl2);
        ATT_LOADV(kb2, ks2);
        f32x16 s;
#pragma unroll
        for (int i = 0; i < 16; ++i) s[i] = 0.f;
#pragma unroll
        for (int d0 = 0; d0 < 8; ++d0) { const bf16x8 qf = *(const LAS bf16x8*)(qrd + (((2 * d0 + h) ^ (r & 15)) * 16)); s = __builtin_amdgcn_mfma_f32_32x32x16_bf16(kf[d0], qf, s, 0, 0, 0); }
        ATT_LOADK(kb2, ks2);
        float tm = -1e30f;
#pragma unroll
        for (int i = 0; i < 16; ++i) { const int kt = kb + ks * crow(i, h); const bool ok = ((unsigned)(kt - tq + hl) <= (unsigned)(2 * hl)) && ((unsigned)kt < (unsigned)SEQ);
            s[i] = ok ? s[i] * SC2 : -1e30f; tm = fmaxf(tm, s[i]); }
        tm = fmaxf(tm, __shfl_xor(tm, 32));
        const float mn = fmaxf(m, tm), alpha = __builtin_amdgcn_exp2f(m - mn); m = mn;
        float rs = 0.f;
#pragma unroll
        for (int i = 0; i < 16; ++i) { s[i] = __builtin_amdgcn_exp2f(s[i] - mn); rs += s[i]; }
        l = l * alpha + rs;
#pragma unroll
        for (int db = 0; db < 4; ++db)
#pragma unroll
            for (int i = 0; i < 16; ++i) o[db][i] *= alpha;
        bf16x8 pf[2];
#pragma unroll
        for (int sx = 0; sx < 2; ++sx) { u32x4 w; w.x = pk2(s[8 * sx + 0], s[8 * sx + 1]); w.y = pk2(s[8 * sx + 2], s[8 * sx + 3]); w.z = pk2(s[8 * sx + 4], s[8 * sx + 5]); w.w = pk2(s[8 * sx + 6], s[8 * sx + 7]);
            pf[sx] = __builtin_bit_cast(bf16x8, w); }
#pragma unroll
        for (int db = 0; db < 4; ++db)
#pragma unroll
            for (int sx = 0; sx < 2; ++sx) { const s16x4 lo = vtr(vrd + ((2 * sx + 0) * 4 + db) * 512), hi = vtr(vrd + ((2 * sx + 1) * 4 + db) * 512);
                const bf16x8 vf = (bf16x8){lo[0], lo[1], lo[2], lo[3], hi[0], hi[1], hi[2], hi[3]};
                o[db] = __builtin_amdgcn_mfma_f32_32x32x16_bf16(vf, pf[sx], o[db], 0, 0, 0); }
        kb = kb2; ks = ks2; hl = hl2;
    }
#undef ATT_LOADK
#undef ATT_LOADV
    l += __shfl_xor(l, 32);
    float scale;
    if (IS_A) { const float mf = fmaxf(m, sink2), a = __builtin_amdgcn_exp2f(m - mf); l = l * a + __builtin_amdgcn_exp2f(sink2 - mf); scale = a / l; }
    else scale = 1.0f / l;
    float q2 = 0.f;
#pragma unroll
    for (int db = 0; db < 4; ++db)
#pragma unroll
        for (int i = 0; i < 16; ++i) { o[db][i] *= scale; q2 += o[db][i] * o[db][i]; }
    q2 += __shfl_xor(q2, 32);
    if (h == 0) sq[(size_t)tq * 16] = q2;
    bf16_t* op = ob + (size_t)tq * DM + 4 * h;
#pragma unroll
    for (int db = 0; db < 4; ++db)
#pragma unroll
        for (int g = 0; g < 4; ++g) { u32x2 w; w.x = pk2(o[db][4 * g + 0], o[db][4 * g + 1]); w.y = pk2(o[db][4 * g + 2], o[db][4 * g + 3]); *(u32x2*)(op + 32 * db + 8 * g) = w; }
}
__device__ __forceinline__ void attn_phase(const bf16_t* proj, const float* sink, bf16_t* ocat, float* ssq, LAS unsigned char* lds, int vb, int nvb) {
    int tid_ = threadIdx.x; asm volatile("" : "+v"(tid_));
    const int tid = tid_, lane = tid & 63, w = __builtin_amdgcn_readfirstlane(tid >> 6);
    LAS unsigned char* vl = lds + w * 16384;
    for (int wi = vb; wi < NB * 2 * (SEQ / 64); wi += nvb) {
        const int b = wi / (2 * (SEQ / 64)), rem = wi % (2 * (SEQ / 64)), g = rem / (SEQ / 64), qb = rem % (SEQ / 64);
        const int hq = 4 * g + (w & 3), qbase = qb * 64 + 32 * (w >> 2);
        attn_item<true>(proj + (size_t)b * SEQ * DIN, C_QA + hq * HD, C_KA + g * HD, C_VA + g * HD, qbase, sink[hq] * 1.4426950408889634f,
                        ocat + (size_t)b * SEQ * DM + hq * HD, ssq + (size_t)b * SEQ * 16 + hq, vl, lane);
    }
    for (int wi = vb; wi < NB * 8 * (SEQ / 512); wi += nvb) {
        const int b = wi / (8 * (SEQ / 512)), rem = wi % (8 * (SEQ / 512)), hh = rem / (SEQ / 512), t0 = (rem % (SEQ / 512)) * 512;
        for (int c = w; c < 16; c += 8)
            attn_item<false>(proj + (size_t)b * SEQ * DIN, C_QB + hh * HD, C_KB + hh * HD, C_VB + hh * HD, t0 + c, 0.f,
                             ocat + (size_t)b * SEQ * DM + 1024 + hh * HD, ssq + (size_t)b * SEQ * 16 + 8 + hh, vl, lane);
    }
}

struct Args { const float* in[16]; float* out; unsigned char* ws; };
__device__ __forceinline__ PrepArgs mk_prep(const Args& a) { PrepArgs p; p.x = a.in[0]; p.p = a.in[1]; p.pos = (const int*)a.in[2]; p.w_in = a.in[3]; p.gn_a = a.in[5]; p.gn_b = a.in[6]; p.w_o = a.in[7];
    p.w1 = a.in[10]; p.w2 = a.in[11]; p.w_ple = a.in[12]; p.w_gate = a.in[13]; p.ws = a.ws; return p; }
extern __shared__ __attribute__((aligned(16))) unsigned char dyn_lds[];
__global__ void __launch_bounds__(512) k_mega(Args a) {
    cg::grid_group grid = cg::this_grid();
    LAS unsigned char* lds = (LAS unsigned char*)dyn_lds;
    const int vb = blockIdx.x, nvb = gridDim.x;
    { const PrepArgs p = mk_prep(a); prep_phase(p, lds, vb, nvb); }
    grid.sync();
    { const g8::Gemm g{(const bf16_t*)(a.ws + WS_XB), (const bf16_t*)(a.ws + WS_WINT), DM, DM, 0, 0, DM / 64, 0};
      g8::StepOrder<1> S; S.init(M, DIN, nvb, vb);
      Epi1 E{(bf16_t*)(a.ws + WS_PROJ), (const float*)(a.ws + WS_ROPE)};
      g8::gemm_phase<Epi1, 1, true>(lds, g, S, E); }
    grid.sync();
    attn_phase((const bf16_t*)(a.ws + WS_PROJ), a.in[4], (bf16_t*)(a.ws + WS_OCAT), (float*)(a.ws + WS_SSQ), lds, vb, nvb);
    grid.sync();
    { const g8::Gemm g{(const bf16_t*)(a.ws + WS_OCAT), (const bf16_t*)(a.ws + WS_WOT), DM, DM, 0, 1024, 16, 16};
      g8::StepOrder<2> S; S.init(M, DM, nvb, vb);
      Epi2 E{a.in[0], a.out, (const float*)(a.ws + WS_SSQ)};
      g8::gemm_phase<Epi2, 2, true>(lds, g, S, E); }
    grid.sync();
    ln_rows(a.out, (bf16_t*)(a.ws + WS_H1B), a.in[8], a.in[9], vb, nvb);
    p_to_hidp(a.in[1], (bf16_t*)(a.ws + WS_HID), vb, nvb);
    grid.sync();
    { const g8::Gemm g{(const bf16_t*)(a.ws + WS_H1B), (const bf16_t*)(a.ws + WS_W13T), DM, DM, 0, 0, DM / 64, 0};
      g8::StepOrder<1> S; S.init(M, N13, nvb, vb);
      Epi3 E{(bf16_t*)(a.ws + WS_HID), (bf16_t*)(a.ws + WS_GATE)};
      g8::gemm_phase<Epi3, 1, true>(lds, g, S, E); }
    grid.sync();
    { const g8::Gemm g{(const bf16_t*)(a.ws + WS_HID), (const bf16_t*)(a.ws + WS_W2T), KH, KH, DFF, 0, PLE / 64, DFF / 64};
      g8::StepOrder<2> S; S.init(M, DM, nvb, vb);
      Epi4 E{(const bf16_t*)(a.ws + WS_GATE), a.out};
      g8::gemm_phase<Epi4, 2, true>(lds, g, S, E); }
    grid.sync();
    ln_rows(a.out, nullptr, a.in[14], a.in[15], vb, nvb);
}

extern "C" void kernel_launch(void* const* d_in, const int* in_sizes, int n_in, void* d_out, int out_size, void* d_ws, size_t ws_size, hipStream_t stream) {
    if (n_in != 16 || out_size != M * DM || ws_size < WS_END) { fprintf(stderr, "kernel_launch: unexpected shapes (n_in %d out %d ws %zu)\n", n_in, out_size, ws_size); return; }
    constexpr int LDS = 131072;
    static int grid_blocks = 0;
    if (!grid_blocks) {
        int dev = 0, cus = 0, per_cu = 0;
        (void)hipGetDevice(&dev);
        (void)hipDeviceGetAttribute(&cus, hipDeviceAttributeMultiprocessorCount, dev);
        (void)hipFuncSetAttribute((const void*)k_mega, hipFuncAttributeMaxDynamicSharedMemorySize, LDS);
        (void)hipOccupancyMaxActiveBlocksPerMultiprocessor(&per_cu, (const void*)k_mega, 512, LDS);
        if (per_cu < 1) { fprintf(stderr, "kernel_launch: occupancy query says %d blocks/CU\n", per_cu); per_cu = 1; }
        grid_blocks = cus * 1;
        fprintf(stderr, "kernel_launch: cus %d per_cu %d grid %d\n", cus, per_cu, grid_blocks);
    }
    Args a{};
    for (int i = 0; i < 16; ++i) a.in[i] = (const float*)d_in[i];
    a.out = (float*)d_out; a.ws = (unsigned char*)d_ws;
    void* args[] = {&a};
    hipError_t e = hipLaunchCooperativeKernel((const void*)k_mega, dim3(grid_blocks), dim3(512), args, LDS, stream);
    if (e != hipSuccess) fprintf(stderr, "cooperative launch failed: %s (grid %d)\n", hipGetErrorString(e), grid_blocks);
}
```

```cpp
#include <hip/hip_runtime.h>
#include <hip/hip_cooperative_groups.h>
namespace cg = cooperative_groups;
#include <cstdio>
#include <cstdint>

#define LAS __attribute__((address_space(3)))
typedef unsigned short bf16_t;
typedef short bf16x8 __attribute__((ext_vector_type(8)));
typedef float f32x4 __attribute__((ext_vector_type(4)));
typedef float f32x2 __attribute__((ext_vector_type(2)));
typedef unsigned u32x4 __attribute__((ext_vector_type(4)));
typedef unsigned u32x2 __attribute__((ext_vector_type(2)));

constexpr int NB = 8, SEQ = 2048, M = NB * SEQ;
constexpr int DM = 2048, DIN = 4608, DFF = 8192, PLE = 256, HD = 128;
constexpr int N13 = DFF + DM;
constexpr int C_QA = 0, C_KA = 1024, C_VA = 1280, C_QB = 1536, C_KB = 2560, C_VB = 3584;
constexpr float ALPHA = 1.18920711500272f;
constexpr float LN_EPS = 1e-5f, RMS_EPS = 1e-6f;
constexpr float SM_SCALE = 0.08838834764831845f;

constexpr size_t MiB = 1u << 20;
constexpr size_t WS_CTL = 0, WS_ROPE = 1 * MiB, WS_SSQ = 3 * MiB, WS_PARTML = 4 * MiB  ;
constexpr size_t WS_WINT = 6 * MiB, WS_WOT = 24 * MiB, WS_W13T = 32 * MiB, WS_W2T = 72 * MiB  ;
constexpr size_t WS_H1B = 113 * MiB, WS_XB = 113 * MiB  , WS_PART = 113 * MiB  , WS_GATE = 177 * MiB;
constexpr size_t WS_PROJ = 241 * MiB, WS_OCAT = 385 * MiB, WS_HID = 241 * MiB  , WS_END = 505 * MiB;
constexpr size_t WS_STAT1 = 105 * MiB  , WS_CSP = 109 * MiB  , WS_RS1 = 112 * MiB  , WS_CSBW = 112 * MiB + 512 * 1024  ;
constexpr int KH = DFF + PLE;

__device__ __forceinline__ unsigned f2bf(float f) { unsigned u = __builtin_bit_cast(unsigned, f); return (u + 0x7fffu + ((u >> 16) & 1u)) >> 16; }
typedef __bf16 bf16x2_t __attribute__((ext_vector_type(2)));
__device__ __forceinline__ unsigned pk2(float lo, float hi) { const f32x2 v = {lo, hi}; return __builtin_bit_cast(unsigned, __builtin_convertvector(v, bf16x2_t)); }
__device__ __forceinline__ float bf2f(unsigned short b) { return __builtin_bit_cast(float, (unsigned)b << 16); }
__device__ __forceinline__ float wave_sum(float v) {
#pragma unroll
    for (int o = 1; o < 64; o <<= 1) v += __shfl_xor(v, o);
    return v;
}
__device__ __forceinline__ float wave_max(float v) {
#pragma unroll
    for (int o = 1; o < 64; o <<= 1) v = fmaxf(v, __shfl_xor(v, o));
    return v;
}

__device__ __forceinline__ void transpose_item(const float* W, int N, bf16_t* WT, int ldk, int koff, int row_off, const float* g, LAS float* scr, int item, int lane,
                                               const float* bvec = nullptr, float* csp = nullptr, int csp_n = 0, int csp_col0 = 0) {
    const int nblk = N / 32, kb = item / nblk, nb = item % nblk, k0 = 64 * kb, n0 = 32 * nb;
    const int c4 = lane & 7, kr = lane >> 3;
    f32x4 cs = {0.f, 0.f, 0.f, 0.f}, bw = {0.f, 0.f, 0.f, 0.f};
    f32x4 v[8];
#pragma unroll
    for (int i = 0; i < 8; ++i) v[i] = *(const f32x4*)(W + (size_t)(k0 + kr + 8 * i) * N + n0 + 4 * c4);
#pragma unroll
    for (int i = 0; i < 8; ++i) { const int kk = kr + 8 * i; f32x4 t = v[i];
        if (csp) bw += t * bvec[k0 + kk];
        if (g) t = t * g[k0 + kk];
        if (csp) { const unsigned p0 = pk2(t[0], t[1]), p1 = pk2(t[2], t[3]);
            cs[0] += bf2f((unsigned short)(p0 & 0xffffu)); cs[1] += bf2f((unsigned short)(p0 >> 16)); cs[2] += bf2f((unsigned short)(p1 & 0xffffu)); cs[3] += bf2f((unsigned short)(p1 >> 16)); }
#pragma unroll
        for (int j = 0; j < 4; ++j) scr[kk * 33 + 4 * c4 + j] = t[j]; }
    if (csp) {
#pragma unroll
        for (int j = 0; j < 4; ++j) { cs[j] += __shfl_xor(cs[j], 8); cs[j] += __shfl_xor(cs[j], 16); cs[j] += __shfl_xor(cs[j], 32); bw[j] += __shfl_xor(bw[j], 8); bw[j] += __shfl_xor(bw[j], 16); bw[j] += __shfl_xor(bw[j], 32); }
        if (lane < 8) { f32x4* cp = (f32x4*)(csp + ((size_t)kb * csp_n + csp_col0 + n0 + 4 * c4) * 2); cp[0] = (f32x4){cs[0], bw[0], cs[1], bw[1]}; cp[1] = (f32x4){cs[2], bw[2], cs[3], bw[3]}; } }
    asm volatile("s_waitcnt lgkmcnt(0)" ::: "memory");
    const int c = lane & 7;
#pragma unroll
    for (int j = 0; j < 4; ++j) { const int n = (lane >> 3) + 8 * j; const LAS float* sp = scr + (8 * c) * 33 + n;
        u32x4 o; o.x = pk2(sp[0 * 33], sp[1 * 33]); o.y = pk2(sp[2 * 33], sp[3 * 33]); o.z = pk2(sp[4 * 33], sp[5 * 33]); o.w = pk2(sp[6 * 33], sp[7 * 33]);
        *(u32x4*)(WT + (size_t)(row_off + n0 + n) * ldk + koff + k0 + 8 * c) = o; }
    asm volatile("s_waitcnt lgkmcnt(0)" ::: "memory");
}
__device__ __forceinline__ void sincos_d(double x, float& s, float& c) {
    const double k = __builtin_rint(x * 0.63661977236758134308);
    double r = __builtin_fma(-k, 1.57079632679489655800e+00, x); r = __builtin_fma(-k, 6.12323399573676603587e-17, r);
    const double r2 = r * r;
    double sp = -1.0 / 1307674368000.0; sp = sp * r2 + 1.0 / 6227020800.0; sp = sp * r2 - 1.0 / 39916800.0; sp = sp * r2 + 1.0 / 362880.0; sp = sp * r2 - 1.0 / 5040.0; sp = sp * r2 + 1.0 / 120.0; sp = sp * r2 - 1.0 / 6.0; sp = sp * r2 + 1.0;
    const double sn = sp * r;
    double cp = 1.0 / 20922789888000.0; cp = cp * r2 - 1.0 / 87178291200.0; cp = cp * r2 + 1.0 / 479001600.0; cp = cp * r2 - 1.0 / 3628800.0; cp = cp * r2 + 1.0 / 40320.0; cp = cp * r2 - 1.0 / 720.0; cp = cp * r2 + 1.0 / 24.0; cp = cp * r2 - 0.5; cp = cp * r2 + 1.0;
    const int q = ((int)k) & 3;
    const double ss = (q == 0) ? sn : (q == 1) ? cp : (q == 2) ? -sn : -cp;
    const double cc = (q == 0) ? cp : (q == 1) ? -sn : (q == 2) ? -cp : sn;
    s = (float)ss; c = (float)cc;
}
struct PrepArgs { const float *x, *p, *w_in, *gn_a, *gn_b, *w_o, *w1, *w2, *w_ple, *w_gate, *ln1_g, *ln1_b; const int* pos; unsigned char* ws; };
__device__ __forceinline__ void prep_phase(const PrepArgs& a, LAS unsigned char* lds, int vb, int nvb) {
    const int tid = threadIdx.x, lane = tid & 63, wave = tid >> 6;
    LAS float* scr = (LAS float*)(lds + wave * 16384);
    const int gw = vb * 8 + wave, ngw = nvb * 8;
    bf16_t* WinT = (bf16_t*)(a.ws + WS_WINT); bf16_t* WoT = (bf16_t*)(a.ws + WS_WOT); bf16_t* W13T = (bf16_t*)(a.ws + WS_W13T); bf16_t* W2T = (bf16_t*)(a.ws + WS_W2T);
    constexpr int I_IN = (DM / 64) * (DIN / 32), I_O = (DM / 64) * (DM / 32), I_1 = (DM / 64) * (DFF / 32), I_G = I_O, I_2 = (DFF / 64) * (DM / 32), I_P = (PLE / 64) * (DM / 32);
    constexpr int NITEMS = I_IN + I_O + I_1 + I_G + I_2 + I_P;
    for (int it = gw; it < NITEMS; it += ngw) {
        int r = it;
        if (r < I_IN) { transpose_item(a.w_in, DIN, WinT, DM, 0, 0, nullptr, scr, r, lane); continue; } r -= I_IN;
        if (r < I_O) { const int kb = r / (DM / 32);
            transpose_item(a.w_o, DM, WoT, DM, 0, 0, (kb < 16) ? a.gn_a : (a.gn_b - 1024), scr, r, lane); continue; } r -= I_O;
        if (r < I_1) { transpose_item(a.w1, DFF, W13T, DM, 0, 0, a.ln1_g, scr, r, lane, a.ln1_b, (float*)(a.ws + WS_CSP), N13, 0); continue; } r -= I_1;
        if (r < I_G) { transpose_item(a.w_gate, DM, W13T, DM, 0, DFF, a.ln1_g, scr, r, lane, a.ln1_b, (float*)(a.ws + WS_CSP), N13, DFF); continue; } r -= I_G;
        if (r < I_2) { transpose_item(a.w2, DM, W2T, KH, 0, 0, nullptr, scr, r, lane); continue; } r -= I_2;
        transpose_item(a.w_ple, DM, W2T, KH, DFF, 0, nullptr, scr, r, lane);
    }
    bf16_t* XB = (bf16_t*)(a.ws + WS_XB);
    const size_t gt = (size_t)vb * 512 + tid, ngt = (size_t)nvb * 512;
    for (size_t i = gt; i < (size_t)M * DM / 8; i += ngt) { const f32x4 v0 = ((const f32x4*)a.x)[2 * i], v1 = ((const f32x4*)a.x)[2 * i + 1];
        u32x4 o; o.x = pk2(v0.x, v0.y); o.y = pk2(v0.z, v0.w); o.z = pk2(v1.x, v1.y); o.w = pk2(v1.z, v1.w); ((u32x4*)XB)[i] = o; }
    float* rope = (float*)(a.ws + WS_ROPE);
    for (size_t i = gt; i < (size_t)M * 16; i += ngt) { const int m = (int)(i >> 4), j = (int)(i & 15);
        const double invf = ::exp2(-(double)j * (1.0 / 16.0) * 18.931568569324174);
        float s, c; sincos_d((double)a.pos[m] * invf, s, c); rope[(size_t)m * 32 + j] = c; rope[(size_t)m * 32 + 16 + j] = s; }
}
__device__ __forceinline__ void p_to_hidp(const float* p, bf16_t* HIDP, int vb, int nvb) {
    const size_t gt = (size_t)vb * 512 + threadIdx.x, ngt = (size_t)nvb * 512;
    for (size_t i = gt; i < (size_t)M * PLE / 8; i += ngt) { const f32x4 v0 = ((const f32x4*)p)[2 * i], v1 = ((const f32x4*)p)[2 * i + 1];
        const size_t row = i / (PLE / 8), c8 = i % (PLE / 8);
        u32x4 o; o.x = pk2(v0.x, v0.y); o.y = pk2(v0.z, v0.w); o.z = pk2(v1.x, v1.y); o.w = pk2(v1.z, v1.w); *(u32x4*)(HIDP + row * KH + DFF + c8 * 8) = o; }
}
namespace g8 {
constexpr int BM = 256, BK = 64, HALF = 128, HTB = HALF * BK * 2  , STAGE_BYTES = 8 * HTB, NXCD = 8, WGM = 8;
__host__ __device__ __forceinline__ int lds_byte(int r, int c) { const int st = (r >> 4) * 2 + (c >> 5), rr = r & 15, cc = c & 31, ob = rr * 64 + cc * 2; return st * 1024 + (ob ^ (((ob >> 9) & 1) << 5)); }
__host__ __device__ __forceinline__ void stage_rc(int b, int& R, int& C) { const int st = b / 1024, sb = b % 1024, swz = sb ^ (((sb >> 9) & 1) << 5); R = (st >> 1) * 16 + swz / 64; C = (st & 1) * 32 + (swz % 64) / 2; }
__host__ __device__ __forceinline__ int perm32(int rho) { const int n = rho >> 4, i = rho & 15; return 8 * (i >> 2) + 4 * n + (i & 3); }
struct Unit { int pm, pn, seg; };
struct Gemm { const bf16_t* A; const bf16_t* Bt; int lda, ldb; int kofs0, kofs1; int nt0, nt1; };
template <int NSEG> struct StepOrder {
    int nM, nN, nwg, G, c;
    __device__ void init(int M_, int N_, int G_, int c_) { nM = M_ / BM; nN = N_ / BM; nwg = nM * nN; G = G_; c = c_; }
    __device__ __forceinline__ bool next(int i, Unit& u) const {
        const int ui = (NSEG == 2) ? (i >> 1) : i; u.seg = (NSEG == 2) ? (i & 1) : 0;
        const long L = (long)ui * G + c; if (L >= nwg) return false;
        int wgid = (int)L; { const int q = nwg / NXCD, r = nwg % NXCD, xcd = wgid % NXCD, off = wgid / NXCD; wgid = (xcd < r ? xcd * (q + 1) : r * (q + 1) + (xcd - r) * q) + off; }
        const int nig = WGM * nN, gid = wgid / nig, fm = gid * WGM, gsz = (nM - fm) < WGM ? (nM - fm) : WGM;
        u.pm = fm + ((wgid % nig) % gsz); u.pn = (wgid % nig) / gsz; return true;
    }
};
template <class Epi, int NSEG, bool ALIGN_EPI>
__device__ __forceinline__ void gemm_phase(LAS unsigned char* lds, const Gemm g, const StepOrder<NSEG>& S, const Epi& E) {
    int tid_ = threadIdx.x; asm volatile("" : "+v"(tid_));
    const int tid = tid_, wid = __builtin_amdgcn_readfirstlane(tid >> 6), lane = tid & 63, wr = wid >> 2, wc = wid & 3, fr = lane & 15, fq = lane >> 4;
    unsigned voffA[2], voffB[2];
#pragma unroll
    for (int i = 0; i < 2; ++i) { int R, C; stage_rc(tid * 16 + i * 8192, R, C); const int Rb = Epi::PERM ? ((R & ~31) + perm32(R & 31)) : R;
        voffA[i] = (unsigned)(R * g.lda + C) * 2u; voffB[i] = (unsigned)(Rb * g.ldb + C) * 2u; }
    const size_t kstep = (size_t)(BK * 2);
    const size_t hstepA = (size_t)HALF * g.lda * 2, hstepB = (size_t)HALF * g.ldb * 2, tstepA = 2 * hstepA, tstepB = 2 * hstepB;
    const unsigned ldsw = (unsigned)wid * 1024u;
    const int aoff = lds_byte(wr * 64 + fr, fq * 8), boff = lds_byte(wc * 32 + fr, fq * 8);
#define PG8_SA(b, h) (((b) * 2 + (h)) * g8::HTB)
#define PG8_SB(b, h) ((4 + (b) * 2 + (h)) * g8::HTB)
#define PG8_STAGE(bufoff, gbase, voff) do { _Pragma("unroll") for (int _i = 0; _i < 2; ++_i) \
        __builtin_amdgcn_global_load_lds((const unsigned*)((const char*)(gbase) + (voff)[_i]), (LAS unsigned*)(lds + (bufoff) + ldsw + _i * 8192), 16, 0, 0); } while (0)
#define PG8_LDA(dst, b, h) do { _Pragma("unroll") for (int m = 0; m < 4; ++m) _Pragma("unroll") for (int k = 0; k < 2; ++k) dst[m][k] = *(const LAS bf16x8*)(lds + PG8_SA(b, h) + aoff + m * 2048 + k * 1024); } while (0)
#define PG8_LDB(dst, b, h) do { _Pragma("unroll") for (int n = 0; n < 2; ++n) _Pragma("unroll") for (int k = 0; k < 2; ++k) dst[n][k] = *(const LAS bf16x8*)(lds + PG8_SB(b, h) + boff + n * 2048 + k * 1024); } while (0)
#define PG8_MMA(ai, bj, At, Bt) do { __builtin_amdgcn_s_setprio(1); _Pragma("unroll") for (int m = 0; m < 4; ++m) _Pragma("unroll") for (int n = 0; n < 2; ++n) _Pragma("unroll") for (int k = 0; k < 2; ++k) \
        acc[ai][bj][m][n] = __builtin_amdgcn_mfma_f32_16x16x32_bf16(Bt[n][k], At[m][k], acc[ai][bj][m][n], 0, 0, 0); __builtin_amdgcn_s_setprio(0); } while (0)
#define PG8_WAIT_V(n) asm volatile("s_waitcnt vmcnt(" #n ")" ::: "memory")
#define PG8_WAIT_L(n) asm volatile("s_waitcnt lgkmcnt(" #n ")" ::: "memory")
#define PG8_BAR __builtin_amdgcn_s_barrier()
#define PG8_SCHED __builtin_amdgcn_sched_barrier(0)
#define PG8_BASEA(u) ((const char*)g.A + (size_t)(u).pm * tstepA + (size_t)((u).seg ? g.kofs1 : g.kofs0) * 2)
#define PG8_BASEB(u) ((const char*)g.Bt + (size_t)(u).pn * tstepB + (size_t)((u).seg ? g.kofs1 : g.kofs0) * 2)
    Unit cur, nxt; int ui = 0;
    if (!S.next(0, cur)) return;
    f32x4 acc[2][2][4][2];
#pragma unroll
    for (int a = 0; a < 2; ++a)
#pragma unroll
        for (int b = 0; b < 2; ++b)
#pragma unroll
            for (int m = 0; m < 4; ++m)
#pragma unroll
                for (int n = 0; n < 2; ++n) acc[a][b][m][n] = (f32x4){0.f, 0.f, 0.f, 0.f};
    bf16x8 At[4][2], B0[2][2], B1[2][2];
    const char* cA = PG8_BASEA(cur); const char* cB = PG8_BASEB(cur);
    PG8_STAGE(PG8_SB(0, 0), cB, voffB); PG8_STAGE(PG8_SB(0, 1), cB + hstepB, voffB); PG8_STAGE(PG8_SA(0, 0), cA, voffA); PG8_STAGE(PG8_SA(0, 1), cA + hstepA, voffA);
    if (wr == 1) PG8_BAR;
    PG8_WAIT_V(2); PG8_BAR;
    PG8_STAGE(PG8_SB(1, 0), cB + kstep, voffB); PG8_STAGE(PG8_SA(1, 0), cA + kstep, voffA); PG8_STAGE(PG8_SB(1, 1), cB + hstepB + kstep, voffB);
    PG8_WAIT_V(6); PG8_BAR;
    for (;;) {
        const bool has_next = S.next(ui + 1, nxt);
        const char* nA = has_next ? PG8_BASEA(nxt) : cA; const char* nB = has_next ? PG8_BASEB(nxt) : cB;
        const int nt = cur.seg ? g.nt1 : g.nt0;
        for (int t = 0; t < nt; t += 2) {
            const bool last = (t == nt - 2);
            const char* a1 = cA + (size_t)(t + 1) * kstep;
            const char* a2 = last ? nA : cA + (size_t)(t + 2) * kstep; const char* b2 = last ? nB : cB + (size_t)(t + 2) * kstep;
            const char* a3 = a2 + kstep; const char* b3 = b2 + kstep;
            PG8_LDB(B0, 0, 0); PG8_LDB(B1, 0, 1); PG8_SCHED; PG8_LDA(At, 0, 0); PG8_STAGE(PG8_SA(1, 1), a1 + hstepA, voffA);
            PG8_WAIT_V(8); PG8_WAIT_L(0); PG8_BAR; PG8_MMA(0, 0, At, B0); PG8_MMA(0, 1, At, B1); PG8_BAR; PG8_SCHED;
            PG8_LDA(At, 0, 1); PG8_STAGE(PG8_SB(0, 0), b2, voffB); PG8_STAGE(PG8_SB(0, 1), b2 + hstepB, voffB); PG8_STAGE(PG8_SA(0, 0), a2, voffA);
            PG8_WAIT_V(8); PG8_WAIT_L(0); PG8_BAR; PG8_MMA(1, 0, At, B0); PG8_MMA(1, 1, At, B1); PG8_BAR; PG8_SCHED;
            PG8_LDB(B0, 1, 0); PG8_LDB(B1, 1, 1); PG8_SCHED; PG8_LDA(At, 1, 0); PG8_STAGE(PG8_SA(0, 1), a2 + hstepA, voffA);
            PG8_WAIT_V(8); PG8_WAIT_L(0); PG8_BAR; PG8_MMA(0, 0, At, B0); PG8_MMA(0, 1, At, B1); PG8_BAR; PG8_SCHED;
            PG8_LDA(At, 1, 1); PG8_STAGE(PG8_SB(1, 0), b3, voffB); PG8_STAGE(PG8_SB(1, 1), b3 + hstepB, voffB); PG8_STAGE(PG8_SA(1, 0), a3, voffA);
            PG8_WAIT_V(8); PG8_WAIT_L(0); PG8_BAR; PG8_MMA(1, 0, At, B0); PG8_MMA(1, 1, At, B1); PG8_BAR; PG8_SCHED;
        }
        if constexpr (ALIGN_EPI) { if (wr == 0) PG8_BAR; }
        const bool fin = (NSEG == 1) || (cur.seg == NSEG - 1);
        if (fin) E(acc, cur, wr, wc, fr, fq); else E.mid(acc, cur, wr, wc, fr, fq);
        if (!has_next) break;
        if (fin) {
#pragma unroll
            for (int a = 0; a < 2; ++a)
#pragma unroll
                for (int b = 0; b < 2; ++b)
#pragma unroll
                    for (int m = 0; m < 4; ++m)
#pragma unroll
                        for (int n = 0; n < 2; ++n) acc[a][b][m][n] = (f32x4){0.f, 0.f, 0.f, 0.f};
        }
        cur = nxt; cA = nA; cB = nB; ++ui;
        if constexpr (ALIGN_EPI) { if (wr == 1) PG8_BAR; }
    }
    PG8_WAIT_V(0);
    if constexpr (!ALIGN_EPI) { if (wr == 0) PG8_BAR; }
    PG8_BAR;
#undef PG8_SA
#undef PG8_SB
#undef PG8_STAGE
#undef PG8_LDA
#undef PG8_LDB
#undef PG8_MMA
#undef PG8_WAIT_V
#undef PG8_WAIT_L
#undef PG8_BAR
#undef PG8_SCHED
#undef PG8_BASEA
#undef PG8_BASEB
}
}

struct Epi1 {
    static constexpr bool PERM = true;
    bf16_t* O; const float* rope;
    __device__ __forceinline__ void mid(f32x4 (&)[2][2][4][2], const g8::Unit&, int, int, int, int) const {}
    __device__ __forceinline__ void operator()(const f32x4 (&acc)[2][2][4][2], const g8::Unit& u, int wr, int wc, int fr, int fq) const {
        const int row0 = u.pm * 256 + wr * 64 + fr, col0 = u.pn * 256 + wc * 32 + 8 * fq;
        const float sgn = fq < 2 ? -1.f : 1.f;
#pragma unroll
        for (int ai = 0; ai < 2; ++ai)
#pragma unroll
            for (int m = 0; m < 4; ++m) {
                const int row = row0 + ai * 128 + m * 16;
                const float* rp = rope + (size_t)row * 32 + 8 * (fq & 1);
                const f32x4 c0 = *(const f32x4*)(rp), c1 = *(const f32x4*)(rp + 4), s0 = *(const f32x4*)(rp + 16), s1 = *(const f32x4*)(rp + 20);
#pragma unroll
                for (int bj = 0; bj < 2; ++bj) {
                    const int hh = 2 * u.pn + bj;
                    const bool is_rope = (wc == 0) && (hh < 10 || (hh >= 12 && hh < 28));
                    f32x4 v0 = acc[ai][bj][m][0], v1 = acc[ai][bj][m][1];
                    if (is_rope) {
                        f32x4 o0, o1;
#pragma unroll
                        for (int j = 0; j < 4; ++j) { o0[j] = __shfl_xor(v0[j], 32); o1[j] = __shfl_xor(v1[j], 32); }
                        v0 = v0 * c0 + (o0 * s0) * sgn; v1 = v1 * c1 + (o1 * s1) * sgn;
                    }
                    u32x4 w; w.x = pk2(v0[0], v0[1]); w.y = pk2(v0[2], v0[3]); w.z = pk2(v1[0], v1[1]); w.w = pk2(v1[2], v1[3]);
                    *(u32x4*)(O + (size_t)row * DIN + col0 + bj * 128) = w;
                }
            }
    }
};
struct Epi2 {
    static constexpr bool PERM = false;
    const float* x; float* V; const float* ssq; bf16_t* VB; float* stat;
    __device__ __forceinline__ void scales(int row, float& ra, float& rb) const {
        const f32x4* sp = (const f32x4*)(ssq + (size_t)row * 16);
        const f32x4 a0 = sp[0], a1 = sp[1], b0 = sp[2], b1 = sp[3];
        const float sa = (a0[0] + a0[1]) + (a0[2] + a0[3]) + (a1[0] + a1[1]) + (a1[2] + a1[3]);
        const float sb = (b0[0] + b0[1]) + (b0[2] + b0[3]) + (b1[0] + b1[1]) + (b1[2] + b1[3]);
        ra = 1.0f / sqrtf(sa * (1.0f / 1024.0f) + RMS_EPS); rb = 1.0f / sqrtf(sb * (1.0f / 1024.0f) + RMS_EPS);
    }
    __device__ __forceinline__ void mid(f32x4 (&acc)[2][2][4][2], const g8::Unit& u, int wr, int wc, int fr, int fq) const {
#pragma unroll
        for (int ai = 0; ai < 2; ++ai)
#pragma unroll
            for (int m = 0; m < 4; ++m) { float ra, rb; scales(u.pm * 256 + ai * 128 + wr * 64 + m * 16 + fr, ra, rb); const float f = ra / rb;
#pragma unroll
                for (int bj = 0; bj < 2; ++bj)
#pragma unroll
                    for (int n = 0; n < 2; ++n) acc[ai][bj][m][n] = acc[ai][bj][m][n] * f; }
    }
    __device__ __forceinline__ void operator()(const f32x4 (&acc)[2][2][4][2], const g8::Unit& u, int wr, int wc, int fr, int fq) const {
        const int col0 = u.pn * 256 + wc * 32 + 4 * fq;
#pragma unroll
        for (int ai = 0; ai < 2; ++ai)
#pragma unroll
            for (int m = 0; m < 4; ++m) { const int row = u.pm * 256 + ai * 128 + wr * 64 + m * 16 + fr; float ra, rb; scales(row, ra, rb);
                float s1 = 0.f, s2 = 0.f;
#pragma unroll
                for (int bj = 0; bj < 2; ++bj)
#pragma unroll
                    for (int n = 0; n < 2; ++n) { const size_t off = (size_t)row * DM + col0 + bj * 128 + n * 16;
                        const f32x4 xv = *(const f32x4*)(x + off); const f32x4 v = xv * ALPHA + acc[ai][bj][m][n] * rb; *(f32x4*)(V + off) = v;
                        u32x2 wv; wv.x = pk2(v[0], v[1]); wv.y = pk2(v[2], v[3]); *(u32x2*)(VB + off) = wv;
                        s1 += (v[0] + v[1]) + (v[2] + v[3]); s2 += (v[0] * v[0] + v[1] * v[1]) + (v[2] * v[2] + v[3] * v[3]); }
                s1 += __shfl_xor(s1, 16); s1 += __shfl_xor(s1, 32); s2 += __shfl_xor(s2, 16); s2 += __shfl_xor(s2, 32);
                if (fq == 0) *(f32x2*)(stat + ((size_t)row * 32 + u.pn * 4 + wc) * 2) = (f32x2){s1, s2}; }
    }
};
struct Epi3 {
    static constexpr bool PERM = true;
    bf16_t* HID; bf16_t* GATE; const float* rs; const float* csbw;
    __device__ __forceinline__ void mid(f32x4 (&)[2][2][4][2], const g8::Unit&, int, int, int, int) const {}
    __device__ __forceinline__ void operator()(const f32x4 (&acc)[2][2][4][2], const g8::Unit& u, int wr, int wc, int fr, int fq) const {
        const bool is_gate = u.pn >= DFF / 256;
        bf16_t* base = is_gate ? GATE : HID; const int ldc = is_gate ? DM : KH; const int colt = (is_gate ? u.pn - DFF / 256 : u.pn) * 256;
        const int row0 = u.pm * 256 + wr * 64 + fr, col0 = colt + wc * 32 + 8 * fq, gcol0 = u.pn * 256 + wc * 32 + 8 * fq;
        f32x4 cb[2][4];
#pragma unroll
        for (int bj = 0; bj < 2; ++bj)
#pragma unroll
            for (int q = 0; q < 4; ++q) cb[bj][q] = *(const f32x4*)(csbw + (size_t)(gcol0 + bj * 128 + 2 * q) * 2);
#pragma unroll
        for (int ai = 0; ai < 2; ++ai)
#pragma unroll
            for (int m = 0; m < 4; ++m) { const int row = row0 + ai * 128 + m * 16; const f32x2 mr = *(const f32x2*)(rs + (size_t)row * 2);
#pragma unroll
                for (int bj = 0; bj < 2; ++bj) { f32x4 v0 = acc[ai][bj][m][0], v1 = acc[ai][bj][m][1];
                    v0[0] = mr[1] * (v0[0] - mr[0] * cb[bj][0][0]) + cb[bj][0][1]; v0[1] = mr[1] * (v0[1] - mr[0] * cb[bj][0][2]) + cb[bj][0][3];
                    v0[2] = mr[1] * (v0[2] - mr[0] * cb[bj][1][0]) + cb[bj][1][1]; v0[3] = mr[1] * (v0[3] - mr[0] * cb[bj][1][2]) + cb[bj][1][3];
                    v1[0] = mr[1] * (v1[0] - mr[0] * cb[bj][2][0]) + cb[bj][2][1]; v1[1] = mr[1] * (v1[1] - mr[0] * cb[bj][2][2]) + cb[bj][2][3];
                    v1[2] = mr[1] * (v1[2] - mr[0] * cb[bj][3][0]) + cb[bj][3][1]; v1[3] = mr[1] * (v1[3] - mr[0] * cb[bj][3][2]) + cb[bj][3][3];
                    if (is_gate) {
#pragma unroll
                        for (int j = 0; j < 4; ++j) { v0[j] = 1.0f / (1.0f + __expf(-v0[j])); v1[j] = 1.0f / (1.0f + __expf(-v1[j])); }
                    } else {
#pragma unroll
                        for (int j = 0; j < 4; ++j) { const float a = fmaxf(v0[j], 0.f), b = fmaxf(v1[j], 0.f); v0[j] = a * a; v1[j] = b * b; }
                    }
                    u32x4 w; w.x = pk2(v0[0], v0[1]); w.y = pk2(v0[2], v0[3]); w.z = pk2(v1[0], v1[1]); w.w = pk2(v1[2], v1[3]);
                    *(u32x4*)(base + (size_t)row * ldc + col0 + bj * 128) = w; } }
    }
};
struct Epi4 {
    static constexpr bool PERM = false;
    const bf16_t* GATE; float* H; const float* rs; const float* g1; const float* b1;
    __device__ __forceinline__ void mid(f32x4 (&acc)[2][2][4][2], const g8::Unit& u, int wr, int wc, int fr, int fq) const {
        const int col0 = u.pn * 256 + wc * 32 + 4 * fq;
#pragma unroll
        for (int ai = 0; ai < 2; ++ai)
#pragma unroll
            for (int m = 0; m < 4; ++m) { const int row = u.pm * 256 + ai * 128 + wr * 64 + m * 16 + fr;
#pragma unroll
                for (int bj = 0; bj < 2; ++bj)
#pragma unroll
                    for (int n = 0; n < 2; ++n) { const u32x2 g = *(const u32x2*)(GATE + (size_t)row * DM + col0 + bj * 128 + n * 16);
                        f32x4 gv; gv[0] = bf2f((unsigned short)(g.x & 0xffff)); gv[1] = bf2f((unsigned short)(g.x >> 16)); gv[2] = bf2f((unsigned short)(g.y & 0xffff)); gv[3] = bf2f((unsigned short)(g.y >> 16));
                        acc[ai][bj][m][n] = acc[ai][bj][m][n] * gv; } }
    }
    __device__ __forceinline__ void operator()(const f32x4 (&acc)[2][2][4][2], const g8::Unit& u, int wr, int wc, int fr, int fq) const {
        const int col0 = u.pn * 256 + wc * 32 + 4 * fq;
        f32x4 gg[2][2], bb[2][2];
#pragma unroll
        for (int bj = 0; bj < 2; ++bj)
#pragma unroll
            for (int n = 0; n < 2; ++n) { gg[bj][n] = *(const f32x4*)(g1 + col0 + bj * 128 + n * 16); bb[bj][n] = *(const f32x4*)(b1 + col0 + bj * 128 + n * 16); }
#pragma unroll
        for (int ai = 0; ai < 2; ++ai)
#pragma unroll
            for (int m = 0; m < 4; ++m) { const int row = u.pm * 256 + ai * 128 + wr * 64 + m * 16 + fr; const f32x2 mr = *(const f32x2*)(rs + (size_t)row * 2);
#pragma unroll
                for (int bj = 0; bj < 2; ++bj)
#pragma unroll
                    for (int n = 0; n < 2; ++n) { const size_t off = (size_t)row * DM + col0 + bj * 128 + n * 16;
                        const f32x4 vv = *(const f32x4*)(H + off); const f32x4 h1 = (vv - mr[0]) * mr[1] * gg[bj][n] + bb[bj][n];
                        *(f32x4*)(H + off) = h1 * ALPHA + acc[ai][bj][m][n]; } }
    }
};

__device__ __forceinline__ void stats_phase(const float* stat, float* rs, const float* csp, float* csbw, const float* p, bf16_t* HIDP, int vb, int nvb) {
    const int gt = vb * 512 + threadIdx.x, ngt = nvb * 512;
    for (int row = gt; row < M; row += ngt) { const f32x4* sp = (const f32x4*)(stat + (size_t)row * 64); float s1 = 0.f, s2 = 0.f;
#pragma unroll
        for (int i = 0; i < 16; ++i) { const f32x4 t = sp[i]; s1 += t[0] + t[2]; s2 += t[1] + t[3]; }
        const float mean = s1 * (1.0f / DM), var = fmaxf(s2 * (1.0f / DM) - mean * mean, 0.f);
        *(f32x2*)(rs + (size_t)row * 2) = (f32x2){mean, 1.0f / sqrtf(var + LN_EPS)}; }
    for (int n = gt; n < N13; n += ngt) { float cs = 0.f, bw = 0.f;
#pragma unroll 8
        for (int kb = 0; kb < DM / 64; ++kb) { const f32x2 t = *(const f32x2*)(csp + ((size_t)kb * N13 + n) * 2); cs += t[0]; bw += t[1]; }
        *(f32x2*)(csbw + (size_t)n * 2) = (f32x2){cs, bw}; }
    p_to_hidp(p, HIDP, vb, nvb);
}
__device__ __forceinline__ void ln_rows(float* V, bf16_t* OB, const float* g, const float* b, int vb, int nvb) {
    const int tid = threadIdx.x, lane = tid & 63, wave = tid >> 6;
    for (int row = vb * 8 + wave; row < M; row += nvb * 8) {
        f32x4* vr = (f32x4*)(V + (size_t)row * DM) + lane;
        f32x4 v[8]; float s = 0.f;
#pragma unroll
        for (int j = 0; j < 8; ++j) { v[j] = vr[64 * j]; s += (v[j][0] + v[j][1]) + (v[j][2] + v[j][3]); }
        const float mean = wave_sum(s) * (1.0f / DM); float s2 = 0.f;
#pragma unroll
        for (int j = 0; j < 8; ++j) { v[j] = v[j] - mean; s2 += (v[j][0] * v[j][0] + v[j][1] * v[j][1]) + (v[j][2] * v[j][2] + v[j][3] * v[j][3]); }
        const float rstd = 1.0f / sqrtf(wave_sum(s2) * (1.0f / DM) + LN_EPS);
#pragma unroll
        for (int j = 0; j < 8; ++j) { const f32x4 gg = ((const f32x4*)g)[lane + 64 * j], bb = ((const f32x4*)b)[lane + 64 * j];
            const f32x4 o = v[j] * rstd * gg + bb; vr[64 * j] = o;
            if (OB) { u32x2 w; w.x = pk2(o[0], o[1]); w.y = pk2(o[2], o[3]); *((u32x2*)(OB + (size_t)row * DM) + lane + 64 * j) = w; } }
    }
}

typedef float f32x16 __attribute__((ext_vector_type(16)));
typedef short s16x4 __attribute__((ext_vector_type(4)));
constexpr float SC2 = SM_SCALE * 1.4426950408889634f;
constexpr int ATT_KOFF = 0, ATT_VOFF = 8192, ATT_BUF = 16384, ATT_STAGE = 65536, ATT_STAGE_W = 32 * 272;
__device__ __forceinline__ int crow(int r, int h) { return (r & 3) + 8 * (r >> 2) + 4 * h; }
__device__ __forceinline__ s16x4 vtr(const LAS unsigned char* p) { return __builtin_bit_cast(s16x4, __builtin_amdgcn_ds_read_tr16_b64_v4i16((LAS s16x4*)p)); }

struct AttItem {
    const bf16_t* pb;
    int qcol, kcol, vcol;
    int s, halo;
    int kb0, tmask, tshift;
    int tb, te;
    int qbase, tlo, thi;
    int orow;
    int head;
    float sink2;
    int pslot;
};
template <int KIND, int PM>
__device__ __forceinline__ void attn_item2(const AttItem& it, bf16_t* ocat, float* ssq, const float* part, const float* partml, float* part_w, float* partml_w, LAS unsigned char* ring, int tid) {
    const int lane = tid & 63, r = lane & 31, h = lane >> 5, w = __builtin_amdgcn_readfirstlane(tid >> 6);
    const int tq = it.qbase + it.s * r;
    asm volatile("s_waitcnt vmcnt(0)" ::: "memory");
    bf16x8 qf[8];
    { const bf16_t* qp = it.pb + (size_t)tq * DIN + it.qcol + 8 * h;
#pragma unroll
      for (int d0 = 0; d0 < 8; ++d0) qf[d0] = *(const bf16x8*)(qp + 16 * d0); }
    f32x16 o[4];
#pragma unroll
    for (int db = 0; db < 4; ++db)
#pragma unroll
        for (int i = 0; i < 16; ++i) o[db][i] = 0.f;
    float m = -1e30f, l = 0.f;
    const int dkk = 4 * w + (lane >> 4), dkc = 8 * ((lane & 15) ^ (dkk & 15));
    const int dvk = 8 * (w >> 1) + ((lane & 31) >> 2), dvc = 32 * (2 * (w & 1) + (lane >> 5)) + 8 * (lane & 3);
    const int krd = ATT_KOFF + r * 256, kx = r & 15;
    const int vrd = ATT_VOFF + (4 * h + ((lane & 15) >> 2)) * 64 + ((lane >> 4) & 1) * 32 + (lane & 3) * 8;
#define ATT_KB(t_) (it.kb0 + 32 * it.s * ((t_) & it.tmask) + ((t_) >> it.tshift))
#define ATT_DMA(t_, buf_) do { const int kb_ = ATT_KB(t_); int k1_ = kb_ + it.s * dkk; k1_ = k1_ < 0 ? 0 : (k1_ > SEQ - 1 ? SEQ - 1 : k1_); int k2_ = kb_ + it.s * dvk; k2_ = k2_ < 0 ? 0 : (k2_ > SEQ - 1 ? SEQ - 1 : k2_); \
        if (PM != 2) __builtin_amdgcn_global_load_lds((const unsigned*)(it.pb + (size_t)k1_ * DIN + it.kcol + dkc), (LAS unsigned*)(ring + (buf_) * ATT_BUF + ATT_KOFF + w * 1024), 16, 0, 0); \
        if (PM != 2) __builtin_amdgcn_global_load_lds((const unsigned*)(it.pb + (size_t)k2_ * DIN + it.vcol + dvc), (LAS unsigned*)(ring + (buf_) * ATT_BUF + ATT_VOFF + w * 1024), 16, 0, 0); } while (0)
    const int nti = it.te - it.tb;
    ATT_DMA(it.tb, 0);
    if (nti > 1) ATT_DMA(it.tb + 1, 1);
    if (nti > 2) ATT_DMA(it.tb + 2, 2);
#pragma unroll
    for (int d0 = 0; d0 < 8; ++d0) asm volatile("" : "+v"(qf[d0]));
#pragma unroll 1
    for (int i = 0; i < nti; ++i) {
        const int t = it.tb + i, cur = i & 3;
        { const int ahead = (nti < i + 3 ? nti : i + 3) - (i + 1);
          if (ahead >= 2) asm volatile("s_waitcnt vmcnt(4)" ::: "memory"); else if (ahead == 1) asm volatile("s_waitcnt vmcnt(2)" ::: "memory"); else asm volatile("s_waitcnt vmcnt(0)" ::: "memory"); }
        __builtin_amdgcn_s_barrier(); asm volatile("" ::: "memory");
        if (i + 3 < nti) ATT_DMA(t + 3, (i + 3) & 3);
        if (PM == 0 && t >= it.tlo && t <= it.thi) {
            const LAS unsigned char* buf = ring + cur * ATT_BUF;
            const int kb = ATT_KB(t);
            f32x16 sc;
#pragma unroll
            for (int j = 0; j < 16; ++j) sc[j] = 0.f;
            { bf16x8 kf[8];
#pragma unroll
              for (int d0 = 0; d0 < 8; ++d0) kf[d0] = *(const LAS bf16x8*)(buf + krd + (((2 * d0 + h) ^ kx) * 16));
#pragma unroll
              for (int d0 = 0; d0 < 8; ++d0) sc = __builtin_amdgcn_mfma_f32_32x32x16_bf16(kf[d0], qf[d0], sc, 0, 0, 0); }
            s16x4 vlo[8], vhi[8];
            { const unsigned va = (unsigned)(size_t)(buf + vrd);
#pragma unroll
              for (int db = 0; db < 4; ++db)
#pragma unroll
                for (int sx = 0; sx < 2; ++sx) {
                    asm volatile("ds_read_b64_tr_b16 %0, %1 offset:%c2" : "=&v"(vlo[db * 2 + sx]) : "v"(va), "i"(((2 * sx + 0) * 4 + db) * 512) : "memory");
                    asm volatile("ds_read_b64_tr_b16 %0, %1 offset:%c2" : "=&v"(vhi[db * 2 + sx]) : "v"(va), "i"(((2 * sx + 1) * 4 + db) * 512) : "memory"); } }
            const int dmax = kb + 31 * it.s - it.qbase, dmin = kb - (it.qbase + 31 * it.s);
            const bool full = (dmax <= it.halo) && (dmin >= -it.halo) && (kb >= 0) && (kb + 31 * it.s < SEQ);
            if (!full) {
#pragma unroll
                for (int j = 0; j < 16; ++j) { const int kt = kb + it.s * crow(j, h); const bool ok = ((unsigned)(kt - tq + it.halo) <= (unsigned)(2 * it.halo)) && ((unsigned)kt < (unsigned)SEQ);
                    sc[j] = ok ? sc[j] : -1e30f; }
            }
            float tm = fmaxf(fmaxf(sc[0], sc[1]), fmaxf(sc[2], sc[3]));
#pragma unroll
            for (int j = 4; j < 16; j += 4) tm = fmaxf(tm, fmaxf(fmaxf(sc[j], sc[j + 1]), fmaxf(sc[j + 2], sc[j + 3])));
            tm = fmaxf(tm, __shfl_xor(tm, 32)) * SC2;
            if (!__all(tm <= m + 8.0f)) {
                const float mn = fmaxf(m, tm), alpha = __builtin_amdgcn_exp2f(m - mn); m = mn; l *= alpha;
#pragma unroll
                for (int db = 0; db < 4; ++db)
#pragma unroll
                    for (int j = 0; j < 16; ++j) o[db][j] *= alpha;
            }
            float rs = 0.f;
#pragma unroll
            for (int j = 0; j < 16; ++j) { sc[j] = __builtin_amdgcn_exp2f(__builtin_fmaf(sc[j], SC2, -m)); rs += sc[j]; }
            l += rs;
            bf16x8 pf[2];
#pragma unroll
            for (int sx = 0; sx < 2; ++sx) { u32x4 wv; wv.x = pk2(sc[8 * sx + 0], sc[8 * sx + 1]); wv.y = pk2(sc[8 * sx + 2], sc[8 * sx + 3]); wv.z = pk2(sc[8 * sx + 4], sc[8 * sx + 5]); wv.w = pk2(sc[8 * sx + 6], sc[8 * sx + 7]);
                pf[sx] = __builtin_bit_cast(bf16x8, wv); }
            asm volatile("s_waitcnt lgkmcnt(0)" ::: "memory"); __builtin_amdgcn_sched_barrier(0);
#pragma unroll
            for (int db = 0; db < 4; ++db)
#pragma unroll
                for (int sx = 0; sx < 2; ++sx) { const s16x4 lo = vlo[db * 2 + sx], hi = vhi[db * 2 + sx];
                    const bf16x8 vf = (bf16x8){lo[0], lo[1], lo[2], lo[3], hi[0], hi[1], hi[2], hi[3]};
                    o[db] = __builtin_amdgcn_mfma_f32_32x32x16_bf16(vf, pf[sx], o[db], 0, 0, 0); }
        }
    }
    asm volatile("s_waitcnt lgkmcnt(0)" ::: "memory"); __builtin_amdgcn_s_barrier(); asm volatile("" ::: "memory");
#undef ATT_KB
#undef ATT_DMA
    l += __shfl_xor(l, 32);
    if (PM == 3) { if (tq == 12345678) ssq[0] = l + o[0][0] + o[1][1] + o[2][2] + o[3][3]; return; }
    if (KIND == 2 || KIND == 3) {
        const int bh = it.pslot >> 3;
        int ws_, rw_;
        if (KIND == 2) { const int c16 = tq & 15, u = tq >> 4; ws_ = (bh * 8 + (c16 >> 1)) * 8 + 4 * (c16 & 1) + (u >> 5); rw_ = u & 31; }
        else           { const int c4 = tq & 3, u4 = tq >> 2; ws_ = (bh * 8 + 2 * c4 + (u4 >> 8)) * 8 + ((u4 >> 5) & 7); rw_ = u4 & 31; }
        const f32x2 ml = *(const f32x2*)(partml + ((size_t)ws_ * 32 + rw_) * 2);
        const float mn = fmaxf(m, ml[0]), fa = __builtin_amdgcn_exp2f(ml[0] - mn), fb = __builtin_amdgcn_exp2f(m - mn);
        l = l * fb + ml[1] * fa; m = mn;
        const f32x4* pp = (const f32x4*)part + (size_t)ws_ * 1024 + 32 * h + rw_;
#pragma unroll
        for (int db = 0; db < 4; ++db)
#pragma unroll
            for (int g = 0; g < 4; ++g) { const f32x4 pa = pp[(db * 4 + g) * 64];
#pragma unroll
                for (int j = 0; j < 4; ++j) o[db][4 * g + j] = o[db][4 * g + j] * fb + pa[j] * fa; }
    }
    if (KIND == 1 || KIND == 2) {
        const int wslot = it.pslot * 8 + w;
        if (h == 0) *(f32x2*)(partml_w + ((size_t)wslot * 32 + r) * 2) = (f32x2){m, l};
        f32x4* pp = (f32x4*)part_w + (size_t)wslot * 1024 + lane;
#pragma unroll
        for (int db = 0; db < 4; ++db)
#pragma unroll
            for (int g = 0; g < 4; ++g) pp[(db * 4 + g) * 64] = (f32x4){o[db][4 * g + 0], o[db][4 * g + 1], o[db][4 * g + 2], o[db][4 * g + 3]};
    } else {
        float scale;
        if (KIND == 0) { const float mf = fmaxf(m, it.sink2), a = __builtin_amdgcn_exp2f(m - mf); l = l * a + __builtin_amdgcn_exp2f(it.sink2 - mf); scale = a / l; }
        else scale = 1.0f / l;
        float q2 = 0.f;
#pragma unroll
        for (int db = 0; db < 4; ++db)
#pragma unroll
            for (int j = 0; j < 16; ++j) { o[db][j] *= scale; q2 += o[db][j] * o[db][j]; }
        q2 += __shfl_xor(q2, 32);
        if (h == 0) ssq[(size_t)(it.orow + tq) * 16 + it.head] = q2;
        LAS unsigned char* stg = ring + ATT_STAGE + w * ATT_STAGE_W;
#pragma unroll
        for (int db = 0; db < 4; ++db)
#pragma unroll
            for (int g = 0; g < 4; ++g) { u32x2 wv; wv.x = pk2(o[db][4 * g + 0], o[db][4 * g + 1]); wv.y = pk2(o[db][4 * g + 2], o[db][4 * g + 3]); *(LAS u32x2*)(stg + r * 272 + (32 * db + 8 * g + 4 * h) * 2) = wv; }
        asm volatile("s_waitcnt lgkmcnt(0)" ::: "memory");
        bf16_t* op = ocat + (size_t)it.orow * DM + it.head * HD + 8 * (lane & 15);
#pragma unroll
        for (int k = 0; k < 8; ++k) { const int row = 4 * k + (lane >> 4); const u32x4 v = *(const LAS u32x4*)(stg + row * 272 + (lane & 15) * 16);
            *(u32x4*)(op + (size_t)(it.qbase + it.s * row) * DM) = v; }
    }
}
__device__ __forceinline__ void att_range(int kb0, int s, int nt, int& tb, int& te) {
    const int w32 = 32 * s; tb = (kb0 + 31 * s >= 0) ? 0 : (-(kb0 + 31 * s) + w32 - 1) / w32; te = (SEQ - kb0 + w32 - 1) / w32; te = te > nt ? nt : te;
}
struct AttBufs { const bf16_t* proj; const float* sink; bf16_t* ocat; float* ssq; float* part; float* partml; float* part_w; float* partml_w; };
template <int PM> __device__ __forceinline__ void att_A(const AttBufs& B, int wi, LAS unsigned char* ring, int tid, int w) {
    const int b = wi >> 6, g = (wi >> 5) & 1, qb = wi & 31, hq = 4 * g + (w & 3), sb = w >> 2;
    AttItem it; it.pb = B.proj + (size_t)b * SEQ * DIN; it.qcol = C_QA + hq * HD; it.kcol = C_KA + g * HD; it.vcol = C_VA + g * HD;
    it.s = 1; it.halo = 128; it.kb0 = 64 * qb - 128; it.tmask = 15; it.tshift = 4; att_range(it.kb0, 1, 10, it.tb, it.te);
    it.qbase = 64 * qb + 32 * sb; it.tlo = sb; it.thi = sb + 8; it.orow = b * SEQ; it.head = hq; it.sink2 = B.sink[hq] * 1.4426950408889634f; it.pslot = 0;
    attn_item2<0, PM>(it, B.ocat, B.ssq, B.part, B.partml, B.part_w, B.partml_w, ring, tid);
}
template <int PM> __device__ __forceinline__ void att_B16(const AttBufs& B, int wi, LAS unsigned char* ring, int tid, int w) {
    const int b = wi >> 6, hh = (wi >> 3) & 7, cp = wi & 7, j = w & 3;
    AttItem it; it.pb = B.proj + (size_t)b * SEQ * DIN; it.qcol = C_QB + hh * HD; it.kcol = C_KB + hh * HD; it.vcol = C_VB + hh * HD;
    it.s = 16; it.halo = 1024; it.kb0 = 2 * cp; it.tmask = 3; it.tshift = 2; it.tb = 0; it.te = 8;
    it.qbase = 2 * cp + (w >> 2) + 512 * j; it.tlo = 4 * (w >> 2) + (j > 2 ? j - 2 : 0); it.thi = 4 * (w >> 2) + (j + 2 < 3 ? j + 2 : 3); it.orow = b * SEQ; it.head = 8 + hh; it.sink2 = 0.f; it.pslot = wi;
    attn_item2<1, PM>(it, B.ocat, B.ssq, B.part, B.partml, B.part_w, B.partml_w, ring, tid);
}
template <int KIND, int PM> __device__ __forceinline__ void att_B41(const AttBufs& B, int wi, LAS unsigned char* ring, int tid, int w) {
    const int b = wi >> 6, hh = (wi >> 3) & 7, sub = wi & 7;
    constexpr int S = (KIND == 2) ? 4 : 1;
    const int c = (KIND == 2) ? (sub >> 1) : 0, blk = (KIND == 2) ? (sub & 1) : sub;
    AttItem it; it.pb = B.proj + (size_t)b * SEQ * DIN; it.qcol = C_QB + hh * HD; it.kcol = C_KB + hh * HD; it.vcol = C_VB + hh * HD;
    it.s = S; it.halo = 64 * S; it.kb0 = c + S * (256 * blk - 64); it.tmask = 15; it.tshift = 4; att_range(it.kb0, S, 12, it.tb, it.te);
    it.qbase = c + S * (256 * blk + 32 * w); it.tlo = w; it.thi = w + 4; it.orow = b * SEQ; it.head = 8 + hh; it.sink2 = 0.f; it.pslot = wi;
    attn_item2<KIND, PM>(it, B.ocat, B.ssq, B.part, B.partml, B.part_w, B.partml_w, ring, tid);
}
template <int SUB, int PM> __device__ __forceinline__ void attn_sub(const AttBufs& B, LAS unsigned char* lds, int vb, int nvb) {
    int tid_ = threadIdx.x; asm volatile("" : "+v"(tid_));
    const int tid = tid_, w = __builtin_amdgcn_readfirstlane(tid >> 6);
    if (SUB == 0) { for (int wi = vb; wi < 512; wi += nvb) att_B16<PM>(B, wi, lds, tid, w);
                    for (int wi = vb; wi < 256; wi += nvb) att_A<PM>(B, wi, lds, tid, w); }
    if (SUB == 1) { for (int wi = vb; wi < 512; wi += nvb) att_B41<2, PM>(B, wi, lds, tid, w); }
    if (SUB == 2) { for (int wi = vb; wi < 512; wi += nvb) att_B41<3, PM>(B, wi, lds, tid, w);
                    for (int wi = 256 + vb; wi < 512; wi += nvb) att_A<PM>(B, wi, lds, tid, w); }
}

struct Args { const float* in[16]; float* out; unsigned char* ws; };
__device__ __forceinline__ PrepArgs mk_prep(const Args& a) { PrepArgs p; p.x = a.in[0]; p.p = a.in[1]; p.pos = (const int*)a.in[2]; p.w_in = a.in[3]; p.gn_a = a.in[5]; p.gn_b = a.in[6]; p.w_o = a.in[7];
    p.ln1_g = a.in[8]; p.ln1_b = a.in[9]; p.w1 = a.in[10]; p.w2 = a.in[11]; p.w_ple = a.in[12]; p.w_gate = a.in[13]; p.ws = a.ws; return p; }
extern __shared__ __attribute__((aligned(16))) unsigned char dyn_lds[];
#define XB_TMO      128
#define XB_XCNT(j)  (256  + 64 * (j))
#define XB_XSUB(j)  (1280 + 64 * (j))
#define XB_XGEN(j)  (2304 + 64 * (j))
#define XB_TOP      3328
#define XB_TOPGEN   3392
#define XCD_BAR_WORDS 3456
#define XB_SPIN_CAP (1u << 18)
__device__ __forceinline__ unsigned xb_ld(unsigned* p)              { return __hip_atomic_load(p, __ATOMIC_RELAXED, __HIP_MEMORY_SCOPE_AGENT); }
__device__ __forceinline__ unsigned xb_add(unsigned* p, unsigned v) { return __hip_atomic_fetch_add(p, v, __ATOMIC_RELAXED, __HIP_MEMORY_SCOPE_AGENT); }
__device__ __forceinline__ unsigned xb_xcc_id() { return (unsigned)__builtin_amdgcn_s_getreg((3 << 11) | 20) & 0xFu; }
#define XB_SPIN(cond, bar) do { unsigned _sp = 0; while (cond) { __builtin_amdgcn_s_sleep(1); \
    if ((++_sp & 255u) == 0u) { if (xb_ld(&(bar)[XB_TMO])) break; if (_sp > XB_SPIN_CAP) { atomicAdd(&(bar)[XB_TMO], 1u); break; } } } } while (0)
struct XcdBarrier { unsigned* bar; unsigned x; volatile LAS unsigned* st; };
__device__ __forceinline__ XcdBarrier xcd_barrier_post(unsigned* bar, volatile LAS unsigned* st) {
    XcdBarrier b; b.bar = bar; b.x = xb_xcc_id(); b.st = st;
    if (threadIdx.x == 0) (void)xb_add(&bar[XB_XCNT(b.x)], 1u);
    return b;
}
__device__ __forceinline__ void xcd_barrier_complete(unsigned* bar, unsigned x, unsigned& nloc, unsigned& nx) {
    const unsigned G = gridDim.x * gridDim.y * gridDim.z;
    unsigned sum, cnt, mine, sp = 0u;
    for (;;) {
        sum = 0u; cnt = 0u; mine = 0u;
#pragma unroll
        for (unsigned j = 0; j < 16; ++j) { const unsigned c = xb_ld(&bar[XB_XCNT(j)]); sum += c; cnt += (c > 0u) ? 1u : 0u; mine = (j == x) ? c : mine; }
        if (sum == G) break;
        __builtin_amdgcn_s_sleep(1);
        if ((++sp & 255u) == 0u) { if (xb_ld(&bar[XB_TMO])) break; if (sp > XB_SPIN_CAP) { atomicAdd(&bar[XB_TMO], 1u); break; } }
    }
    nloc = mine > 0u ? mine : 1u; nx = cnt > 0u ? cnt : 1u;
}
__device__ __forceinline__ void xcd_barrier(const XcdBarrier& b) {
    asm volatile("s_waitcnt vmcnt(0)" ::: "memory");
    __syncthreads();
    if (threadIdx.x == 0) {
        unsigned* bar = b.bar;
        __builtin_amdgcn_s_waitcnt(0);
        unsigned nloc = b.st[0], nx = b.st[1];
        if (nloc == 0u) { xcd_barrier_complete(bar, b.x, nloc, nx); b.st[0] = nloc; b.st[1] = nx; }
        const unsigned old = xb_add(&bar[XB_XSUB(b.x)], 1u);
        const unsigned gen = old / nloc;
        if (old + 1u == (gen + 1u) * nloc) {
            __builtin_amdgcn_fence(__ATOMIC_RELEASE, "agent");
            asm volatile("s_waitcnt vmcnt(0)" ::: "memory");
            const unsigned og = xb_add(&bar[XB_TOP], 1u);
            const unsigned tg = og / nx;
            if (og + 1u == (tg + 1u) * nx) xb_add(&bar[XB_TOPGEN], 1u);
            else XB_SPIN(xb_ld(&bar[XB_TOPGEN]) == tg, bar);
            __builtin_amdgcn_fence(__ATOMIC_ACQUIRE, "agent");
            xb_add(&bar[XB_XGEN(b.x)], 1u);
            asm volatile("s_waitcnt vmcnt(0)" ::: "memory");
        } else {
            XB_SPIN(xb_ld(&bar[XB_XGEN(b.x)]) == gen, bar);
            __builtin_amdgcn_fence(__ATOMIC_ACQUIRE, "agent");
            asm volatile("s_waitcnt vmcnt(0)" ::: "memory");
        }
    }
    __syncthreads();
}

constexpr int LDS_MISC = 139264;
#ifndef REP0
#define REP0 1
#endif
#ifndef REP1
#define REP1 1
#endif
#ifndef REP2
#define REP2 1
#endif
#ifndef REP3
#define REP3 1
#endif
#ifndef REP5
#define REP5 1
#endif
__global__ void __launch_bounds__(512) k_mega(Args a) {
    cg::grid_group grid = cg::this_grid();
    LAS unsigned char* lds = (LAS unsigned char*)dyn_lds;
    const int vb = blockIdx.x, nvb = gridDim.x;
    volatile LAS unsigned* MISC = (volatile LAS unsigned*)(lds + LDS_MISC);
    if (threadIdx.x < 64) MISC[threadIdx.x] = 0u;
    __syncthreads();
    const XcdBarrier bar = xcd_barrier_post((unsigned*)(a.ws + WS_CTL) + 4096, MISC + 8);
    for (int rep = 0; rep < REP0; ++rep) { { const PrepArgs p = mk_prep(a); prep_phase(p, lds, vb, nvb); }
    grid.sync(); }
    for (int rep = 0; rep < REP1; ++rep) { { const g8::Gemm g{(const bf16_t*)(a.ws + WS_XB), (const bf16_t*)(a.ws + WS_WINT), DM, DM, 0, 0, DM / 64, 0};
      g8::StepOrder<1> S; S.init(M, DIN, nvb, vb);
      Epi1 E{(bf16_t*)(a.ws + WS_PROJ), (const float*)(a.ws + WS_ROPE)};
      g8::gemm_phase<Epi1, 1, true>(lds, g, S, E); }
    xcd_barrier(bar); }
    { float* PR1 = (float*)(a.ws + WS_PART); float* PR2 = (float*)(a.ws + WS_GATE); float* PM1 = (float*)(a.ws + WS_PARTML); float* PM2 = (float*)(a.ws + WS_PARTML + MiB);
      const bf16_t* PJ = (const bf16_t*)(a.ws + WS_PROJ); bf16_t* OC = (bf16_t*)(a.ws + WS_OCAT); float* SQ = (float*)(a.ws + WS_SSQ);
      { const AttBufs AB{PJ, a.in[4], OC, SQ, nullptr, nullptr, PR1, PM1}; attn_sub<0, 0>(AB, lds, vb, nvb); } xcd_barrier(bar);
      { const AttBufs AB{PJ, a.in[4], OC, SQ, PR1, PM1, PR2, PM2};         attn_sub<1, 0>(AB, lds, vb, nvb); } xcd_barrier(bar);
      { const AttBufs AB{PJ, a.in[4], OC, SQ, PR2, PM2, nullptr, nullptr}; attn_sub<2, 0>(AB, lds, vb, nvb); } xcd_barrier(bar);
#ifdef PROBE_SUB
      { float* DUM = PR1; float* DML = PM1;
        const AttBufs AD{PJ, a.in[4], (bf16_t*)DUM, DML, PR2, PM2, DUM, DML};
        attn_sub<PROBE_SUB, PROBE_PM>(AD, lds, vb, nvb); xcd_barrier(bar); }
#endif
    }
    for (int rep = 0; rep < REP3; ++rep) { { const g8::Gemm g{(const bf16_t*)(a.ws + WS_OCAT), (const bf16_t*)(a.ws + WS_WOT), DM, DM, 0, 1024, 16, 16};
      g8::StepOrder<2> S; S.init(M, DM, nvb, vb);
      Epi2 E{a.in[0], a.out, (const float*)(a.ws + WS_SSQ), (bf16_t*)(a.ws + WS_H1B), (float*)(a.ws + WS_STAT1)};
      g8::gemm_phase<Epi2, 2, true>(lds, g, S, E); }
    xcd_barrier(bar); }
    stats_phase((const float*)(a.ws + WS_STAT1), (float*)(a.ws + WS_RS1), (const float*)(a.ws + WS_CSP), (float*)(a.ws + WS_CSBW), a.in[1], (bf16_t*)(a.ws + WS_HID), vb, nvb);
    xcd_barrier(bar);
    for (int rep = 0; rep < REP5; ++rep) { { const g8::Gemm g{(const bf16_t*)(a.ws + WS_H1B), (const bf16_t*)(a.ws + WS_W13T), DM, DM, 0, 0, DM / 64, 0};
      g8::StepOrder<1> S; S.init(M, N13, nvb, vb);
      Epi3 E{(bf16_t*)(a.ws + WS_HID), (bf16_t*)(a.ws + WS_GATE), (const float*)(a.ws + WS_RS1), (const float*)(a.ws + WS_CSBW)};
      g8::gemm_phase<Epi3, 1, true>(lds, g, S, E); }
    xcd_barrier(bar); }
    { const g8::Gemm g{(const bf16_t*)(a.ws + WS_HID), (const bf16_t*)(a.ws + WS_W2T), KH, KH, DFF, 0, PLE / 64, DFF / 64};
      g8::StepOrder<2> S; S.init(M, DM, nvb, vb);
      Epi4 E{(const bf16_t*)(a.ws + WS_GATE), a.out, (const float*)(a.ws + WS_RS1), a.in[8], a.in[9]};
      g8::gemm_phase<Epi4, 2, true>(lds, g, S, E); }
    xcd_barrier(bar);
    ln_rows(a.out, nullptr, a.in[14], a.in[15], vb, nvb);
}

extern "C" void kernel_launch(void* const* d_in, const int* in_sizes, int n_in, void* d_out, int out_size, void* d_ws, size_t ws_size, hipStream_t stream) {
    if (n_in != 16 || out_size != M * DM || ws_size < WS_END) { fprintf(stderr, "kernel_launch: unexpected shapes (n_in %d out %d ws %zu)\n", n_in, out_size, ws_size); return; }
    constexpr int LDS = LDS_MISC + 256;
    static int grid_blocks = 0;
    if (!grid_blocks) {
        int dev = 0, cus = 0, per_cu = 0;
        (void)hipGetDevice(&dev);
        (void)hipDeviceGetAttribute(&cus, hipDeviceAttributeMultiprocessorCount, dev);
        (void)hipFuncSetAttribute((const void*)k_mega, hipFuncAttributeMaxDynamicSharedMemorySize, LDS);
        (void)hipOccupancyMaxActiveBlocksPerMultiprocessor(&per_cu, (const void*)k_mega, 512, LDS);
        if (per_cu < 1) { fprintf(stderr, "kernel_launch: occupancy query says %d blocks/CU\n", per_cu); per_cu = 1; }
        grid_blocks = cus * 1;
        fprintf(stderr, "kernel_launch: cus %d per_cu %d grid %d\n", cus, per_cu, grid_blocks);
    }
    Args a{};
    for (int i = 0; i < 16; ++i) a.in[i] = (const float*)d_in[i];
    a.out = (float*)d_out; a.ws = (unsigned char*)d_ws;
    (void)hipMemsetAsync((char*)d_ws + WS_CTL, 0, 65536, stream);
    void* args[] = {&a};
    hipError_t e = hipLaunchCooperativeKernel((const void*)k_mega, dim3(grid_blocks), dim3(512), args, LDS, stream);
    if (e != hipSuccess) fprintf(stderr, "cooperative launch failed: %s (grid %d)\n", hipGetErrorString(e), grid_blocks);
}
```
